# Optimizing an MI355X kernel written in HIP

```python
import math
import jax, jax.numpy as jnp
from jax import lax
import numpy as np

D_MODEL = 1024
BATCH = 32
SEQ = 2048
DEPTH = 4
DEC_BATCH = 8
DEC_SEQ = 2048
PAST_LEN = 128

N_MIXERS = 2
N_CONV_LAYERS = (DEPTH + 1) // 2
N_SSM_LAYERS = DEPTH // 2
SSM_GROUP = 16
SSM_GROUPS = D_MODEL // SSM_GROUP
SSM_STATE = 64
N_DIR = 2
FFN_HIDDEN = 2816
DEEPNORM_ALPHA = (2 * DEPTH) ** 0.25
DEEPNORM_BETA = (8 * DEPTH) ** -0.25
LN_EPS = 1e-5
DT_MIN = 1e-3
DT_MAX = 1e-1

kernel_name = "hybrid_shortconv_s5_convffn_encoder"


def _layer_norm(x, g, b):
    xf = x.astype(jnp.float32)
    mu = jnp.mean(xf, axis=-1, keepdims=True)
    var = jnp.mean(jnp.square(xf - mu), axis=-1, keepdims=True)
    y = (xf - mu) * lax.rsqrt(var + LN_EPS)
    return (y * g.astype(jnp.float32) + b.astype(jnp.float32)).astype(x.dtype)


def _conv3(x, w, b):
    xp = jnp.pad(x, ((0, 0), (1, 1), (0, 0)))
    return xp[:, :-2] * w[0] + xp[:, 1:-1] * w[1] + xp[:, 2:] * w[2] + b


def _short_conv_mixer(u, w_in, conv_w, conv_b, w_out):
    bgate, cgate, h = jnp.split(u @ w_in, 3, axis=-1)
    return (bgate * _conv3(cgate * h, conv_w, conv_b)) @ w_out


def _cmul(ar, ai, br, bi):
    return ar * br - ai * bi, ar * bi + ai * br


def _scan_combine(e1, e2):
    a1r, a1i, b1r, b1i = e1
    a2r, a2i, b2r, b2i = e2
    ar, ai = _cmul(a1r, a1i, a2r, a2i)
    br, bi = _cmul(a2r, a2i, b1r, b1i)
    return ar, ai, br + b2r, bi + b2i


def _s5_sequence(u, a_re, a_im, log_dt, b_re, b_im, c_re, c_im, d_skip):
    f32 = jnp.float32
    L = u.shape[0]
    uf = u.astype(f32)
    ug = uf.reshape(L, SSM_GROUPS, SSM_GROUP)
    y = d_skip.astype(f32) * uf
    for k in range(N_DIR):
        lam_re = a_re[k].astype(f32)
        lam_im = a_im[k].astype(f32)
        dt = jnp.exp(log_dt[k].astype(f32))[:, None]
        mag = jnp.exp(lam_re * dt)
        ang = lam_im * dt
        lb_re = mag * jnp.cos(ang)
        lb_im = mag * jnp.sin(ang)
        den = lam_re * lam_re + lam_im * lam_im
        f_re = ((lb_re - 1.0) * lam_re + lb_im * lam_im) / den
        f_im = (lb_im * lam_re - (lb_re - 1.0) * lam_im) / den
        bu_re = jnp.einsum('lgi,gpi->lgp', ug, b_re[k].astype(f32))
        bu_im = jnp.einsum('lgi,gpi->lgp', ug, b_im[k].astype(f32))
        v_re, v_im = _cmul(f_re, f_im, bu_re, bu_im)
        if k == 1:
            v_re = jnp.flip(v_re, axis=0)
            v_im = jnp.flip(v_im, axis=0)
        shape = v_re.shape
        _, _, s_re, s_im = lax.associative_scan(
            _scan_combine,
            (jnp.broadcast_to(lb_re, shape), jnp.broadcast_to(lb_im, shape), v_re, v_im),
            axis=0)
        if k == 1:
            s_re = jnp.flip(s_re, axis=0)
            s_im = jnp.flip(s_im, axis=0)
        y_dir = (jnp.einsum('lgp,gip->lgi', s_re, c_re[k].astype(f32))
                 - jnp.einsum('lgp,gip->lgi', s_im, c_im[k].astype(f32)))
        y = y + y_dir.reshape(L, D_MODEL)
    return y.astype(u.dtype)


def _s5_mixer(u, a_re, a_im, log_dt, b_re, b_im, c_re, c_im, d_skip, w_glu):
    y = lax.map(lambda us: _s5_sequence(us, a_re, a_im, log_dt, b_re, b_im, c_re, c_im, d_skip), u)
    z = jax.nn.gelu(y)
    val, gate = jnp.split(z @ w_glu, 2, axis=-1)
    return val * jax.nn.sigmoid(gate)


def _conv_ffn(u, w_up, conv_w, conv_b, w_down):
    a, v = jnp.split(_conv3(u @ w_up, conv_w, conv_b), 2, axis=-1)
    return (jax.nn.gelu(a) * v) @ w_down


def _trunk(x, c, ada_w, ada_b, ln1_g, ln1_b, ln2_g, ln2_b,
           sc_w_in, sc_conv_w, sc_conv_b, sc_w_out,
           s5_a_re, s5_a_im, s5_log_dt, s5_b_re, s5_b_im, s5_c_re, s5_c_im, s5_d, s5_w_glu,
           ffn_w_up, ffn_conv_w, ffn_conv_b, ffn_w_down):
    c_act = jax.nn.silu(c)
    for i in range(DEPTH):
        mod = (c_act @ ada_w[i] + ada_b[i])[:, None, :]
        sh1, sc1, g1, sh2, sc2, g2 = jnp.split(mod, 6, axis=-1)
        j = i // N_MIXERS
        u = x * (1.0 + sc1) + sh1
        if i % N_MIXERS == 0:
            m = _short_conv_mixer(u, sc_w_in[j], sc_conv_w[j], sc_conv_b[j], sc_w_out[j])
        else:
            m = _s5_mixer(u, s5_a_re[j], s5_a_im[j], s5_log_dt[j], s5_b_re[j], s5_b_im[j],
                          s5_c_re[j], s5_c_im[j], s5_d[j], s5_w_glu[j])
        x = _layer_norm(DEEPNORM_ALPHA * x + (1.0 + g1) * m, ln1_g[i], ln1_b[i])
        u = x * (1.0 + sc2) + sh2
        f = _conv_ffn(u, ffn_w_up[i], ffn_conv_w[i], ffn_conv_b[i], ffn_w_down[i])
        x = _layer_norm(DEEPNORM_ALPHA * x + (1.0 + g2) * f, ln2_g[i], ln2_b[i])
    return x


def setup_inputs(seed: int = 0) -> dict:
    key = jax.random.key(seed)
    ks = jax.random.split(key, 28)
    f32 = jnp.float32
    D, F, G, P, I = D_MODEL, FFN_HIDDEN, SSM_GROUPS, SSM_STATE, SSM_GROUP
    NC, NS = N_CONV_LAYERS, N_SSM_LAYERS

    def nrm(k, shape, s):
        return jax.random.normal(k, shape, f32) * s

    n_idx = jnp.arange(P, dtype=f32)
    return {
        "x_prompt": nrm(ks[0], (BATCH, SEQ, D), 1.0),
        "x_sample": nrm(ks[1], (DEC_BATCH, DEC_SEQ, D), 1.0),
        "c_prompt": nrm(ks[2], (BATCH, D), 1.0),
        "c_sample": nrm(ks[3], (DEC_BATCH, D), 1.0),
        "ada_w": nrm(ks[4], (DEPTH, D, 6 * D), 0.1 * D ** -0.5),
        "ada_b": nrm(ks[5], (DEPTH, 6 * D), 0.01),
        "ln1_g": 1.0 + nrm(ks[6], (DEPTH, D), 0.02),
        "ln1_b": nrm(ks[7], (DEPTH, D), 0.02),
        "ln2_g": 1.0 + nrm(ks[8], (DEPTH, D), 0.02),
        "ln2_b": nrm(ks[9], (DEPTH, D), 0.02),
        "sc_w_in": nrm(ks[10], (NC, D, 3 * D), D ** -0.5),
        "sc_conv_w": nrm(ks[11], (NC, 3, D), 3 ** -0.5),
        "sc_conv_b": nrm(ks[12], (NC, D), 0.02),
        "sc_w_out": nrm(ks[13], (NC, D, D), DEEPNORM_BETA * D ** -0.5),
        "s5_a_re": -0.5 + nrm(ks[14], (NS, N_DIR, G, P), 0.01),
        "s5_a_im": math.pi * n_idx + nrm(ks[15], (NS, N_DIR, G, P), 0.01),
        "s5_log_dt": jax.random.uniform(ks[16], (NS, N_DIR, G), f32,
                                        math.log(DT_MIN), math.log(DT_MAX)),
        "s5_b_re": nrm(ks[17], (NS, N_DIR, G, P, I), (2 * I) ** -0.5),
        "s5_b_im": nrm(ks[18], (NS, N_DIR, G, P, I), (2 * I) ** -0.5),
        "s5_c_re": nrm(ks[19], (NS, N_DIR, G, I, P), P ** -0.5),
        "s5_c_im": nrm(ks[20], (NS, N_DIR, G, I, P), P ** -0.5),
        "s5_d": nrm(ks[21], (NS, D), 1.0),
        "s5_w_glu": nrm(ks[22], (NS, D, 2 * D), DEEPNORM_BETA * D ** -0.5),
        "ffn_w_up": nrm(ks[23], (DEPTH, D, 2 * F), D ** -0.5),
        "ffn_conv_w": nrm(ks[24], (DEPTH, 3, 2 * F), 3 ** -0.5),
        "ffn_conv_b": nrm(ks[25], (DEPTH, 2 * F), 0.02),
        "ffn_w_down": nrm(ks[26], (DEPTH, F, D), DEEPNORM_BETA * F ** -0.5),
    }


def reference(x_prompt, x_sample, c_prompt, c_sample, ada_w, ada_b, ln1_g, ln1_b, ln2_g, ln2_b,
              sc_w_in, sc_conv_w, sc_conv_b, sc_w_out,
              s5_a_re, s5_a_im, s5_log_dt, s5_b_re, s5_b_im, s5_c_re, s5_c_im, s5_d, s5_w_glu,
              ffn_w_up, ffn_conv_w, ffn_conv_b, ffn_w_down):
    y_prompt = _trunk(x_prompt, c_prompt, ada_w, ada_b, ln1_g, ln1_b, ln2_g, ln2_b,
                      sc_w_in, sc_conv_w, sc_conv_b, sc_w_out,
                      s5_a_re, s5_a_im, s5_log_dt, s5_b_re, s5_b_im, s5_c_re, s5_c_im, s5_d, s5_w_glu,
                      ffn_w_up, ffn_conv_w, ffn_conv_b, ffn_w_down)
    y_sample = _trunk(x_sample, c_sample, ada_w, ada_b, ln1_g, ln1_b, ln2_g, ln2_b,
                      sc_w_in, sc_conv_w, sc_conv_b, sc_w_out,
                      s5_a_re, s5_a_im, s5_log_dt, s5_b_re, s5_b_im, s5_c_re, s5_c_im, s5_d, s5_w_glu,
                      ffn_w_up, ffn_conv_w, ffn_conv_b, ffn_w_down)
    return (y_prompt, y_sample)
```

```cpp
#include <hip/hip_runtime.h>
#include <hip/hip_cooperative_groups.h>
#include <cstdio>
namespace cg = cooperative_groups;

#define LAS __attribute__((address_space(3)))
typedef unsigned short bf16_t;
typedef short bf16x8 __attribute__((ext_vector_type(8)));
typedef float f32x4 __attribute__((ext_vector_type(4)));
typedef unsigned u32x4 __attribute__((ext_vector_type(4)));
typedef unsigned u32x2 __attribute__((ext_vector_type(2)));
typedef float f32x2 __attribute__((ext_vector_type(2)));

constexpr int D = 1024, F = 2816, F2 = 5632, MT = 81920, NSEQ = 40, SEQL = 2048, NPROMPT_ROWS = 65536;
constexpr int DEPTH = 4;
constexpr int TCH = 32, NCHUNK = 64, XR = NSEQ * NCHUNK  , XLD = 768, NG = 64;
constexpr float ALPHA = 1.681792830507429f;
constexpr float LN_EPS = 1e-5f;
constexpr int NTHREADS = 512;
constexpr int LDS_STAGE = 131072, LDS_CW = LDS_STAGE + 16, LDS_BYTES = LDS_CW + 8 * 1024;

constexpr size_t SZ_WIN = (size_t)3072 * 1024 * 2, SZ_WOUT = (size_t)1024 * 1024 * 2, SZ_WGLU = (size_t)2048 * 1024 * 2;
constexpr size_t SZ_WUP = (size_t)F2 * 1024 * 2, SZ_WDN = (size_t)1024 * F * 2;
constexpr size_t SZ_EMAT = (size_t)NG * 256 * 512 * 2, SZ_YMAT = (size_t)NG * 512 * XLD * 2, SZ_KTAB = (size_t)NG * 2 * 32 * 256 * 4;
constexpr size_t WS_WIN = 0;
constexpr size_t WS_WOUT = WS_WIN + 2 * SZ_WIN;
constexpr size_t WS_WGLU = WS_WOUT + 2 * SZ_WOUT;
constexpr size_t WS_EMAT = WS_WGLU + 2 * SZ_WGLU;
constexpr size_t WS_YMAT = WS_EMAT + 2 * SZ_EMAT;
constexpr size_t WS_KTAB = WS_YMAT + 2 * SZ_YMAT;
constexpr size_t WS_WUP = WS_KTAB + 2 * SZ_KTAB;
constexpr size_t WS_WDN = WS_WUP + 4 * SZ_WUP;
constexpr size_t WS_MOD = WS_WDN + 4 * SZ_WDN;
constexpr size_t WS_DEAD = 0;
static_assert(WS_WUP - WS_DEAD >= (size_t)MT * D * 2, "the dead-weights region must hold one bf16 [MT][D] tensor");
constexpr size_t WS_STAT = WS_MOD + (size_t)DEPTH * NSEQ * 6 * D * 4;
constexpr size_t WS_A = WS_STAT + (size_t)MT * 2 * 4;
constexpr size_t WS_EB = WS_A + (size_t)MT * D * 2;
constexpr size_t WS_BIG = WS_A + (size_t)NG * XR * XLD * 2;
constexpr size_t BIG_Z = (size_t)NG * XR * 256 * 4;
constexpr size_t WS_END = WS_BIG + (size_t)MT * 3072 * 2;
constexpr size_t WS_BAR = (WS_END + 255) / 256 * 256, WS_TOTAL = WS_BAR + 16384;
constexpr int NQ = MT / 64;
static_assert((size_t)NQ * 2 * 2 * F2 * 2 <= (size_t)NG * XR * XLD * 2 - (size_t)MT * D * 2, "edge buffer must fit in the A spare");
static_assert((size_t)MT * F * 2 <= (size_t)MT * 3072 * 2, "gbuf fits BIG");

struct Params {
    const float* in[27];
    float* out;
    unsigned char* ws;
};
typedef const __attribute__((address_space(4))) Params* PP;

__device__ __forceinline__ int fresh_lane() { int l; asm volatile("v_mbcnt_lo_u32_b32 %0, -1, 0\n\tv_mbcnt_hi_u32_b32 %0, -1, %0" : "=v"(l)); return l; }
__device__ __forceinline__ int fresh_tid(int wid) { return wid * 64 + fresh_lane(); }
__device__ __forceinline__ float wave_sum_dpp(float v) {
    v += __builtin_bit_cast(float, __builtin_amdgcn_update_dpp(0, __builtin_bit_cast(int, v), 0x111, 0xf, 0xf, true));
    v += __builtin_bit_cast(float, __builtin_amdgcn_update_dpp(0, __builtin_bit_cast(int, v), 0x112, 0xf, 0xf, true));
    v += __builtin_bit_cast(float, __builtin_amdgcn_update_dpp(0, __builtin_bit_cast(int, v), 0x114, 0xf, 0xf, true));
    v += __builtin_bit_cast(float, __builtin_amdgcn_update_dpp(0, __builtin_bit_cast(int, v), 0x118, 0xf, 0xf, true));
    v += __builtin_bit_cast(float, __builtin_amdgcn_update_dpp(0, __builtin_bit_cast(int, v), 0x142, 0xa, 0xf, false));
    v += __builtin_bit_cast(float, __builtin_amdgcn_update_dpp(0, __builtin_bit_cast(int, v), 0x143, 0xc, 0xf, false));
    return __builtin_bit_cast(float, __builtin_amdgcn_readlane(__builtin_bit_cast(int, v), 63));
}
__device__ __forceinline__ float xor_shfl(float x, int lane, int o) { return __builtin_bit_cast(float, __builtin_amdgcn_ds_bpermute((lane ^ o) << 2, __builtin_bit_cast(int, x))); }
__device__ __forceinline__ unsigned cvt_pk_bf16(float lo, float hi) { unsigned r; asm volatile("v_cvt_pk_bf16_f32 %0, %1, %2" : "=v"(r) : "v"(lo), "v"(hi)); return r; }
__device__ __forceinline__ void unpack8(const u32x4 v, float (&f)[8]) {
#pragma unroll
    for (int i = 0; i < 4; ++i) { f[2 * i] = __uint_as_float(v[i] << 16); f[2 * i + 1] = __uint_as_float(v[i] & 0xffff0000u); }
}
__device__ __forceinline__ u32x4 pack8(const float (&f)[8]) {
    u32x4 r;
#pragma unroll
    for (int i = 0; i < 4; ++i) r[i] = cvt_pk_bf16(f[2 * i], f[2 * i + 1]);
    return r;
}
__device__ __forceinline__ float gelu_tanh(float x) { const float z = x * ((x * x) * (-0.10294324f) + (-2.3022082f)); return x * __builtin_amdgcn_rcpf(1.f + __builtin_amdgcn_exp2f(z)); }
__device__ __forceinline__ float sigmoid_f(float x) { return 1.f / (1.f + __expf(-x)); }
__device__ __forceinline__ float dpp_prev(float x) { return __builtin_bit_cast(float, __builtin_amdgcn_mov_dpp(__builtin_bit_cast(int, x), 0x121, 0xf, 0xf, true)); }
__device__ __forceinline__ float dpp_next(float x) { return __builtin_bit_cast(float, __builtin_amdgcn_mov_dpp(__builtin_bit_cast(int, x), 0x12F, 0xf, 0xf, true)); }
__device__ __forceinline__ void conv4(const float (&x)[4], float w0, float w1, float w2, float b, int fr, float (&c)[4]) {
    float R[4], L[4];
#pragma unroll
    for (int m = 0; m < 4; ++m) { R[m] = dpp_prev(x[m]); L[m] = dpp_next(x[m]); }
#pragma unroll
    for (int m = 0; m < 4; ++m) {
        const float pv = fr > 0 ? R[m] : (m > 0 ? R[m > 0 ? m - 1 : 0] : 0.f);
        const float nx = fr < 15 ? L[m] : (m < 3 ? L[m < 3 ? m + 1 : 3] : 0.f);
        c[m] = b + w1 * x[m] + w0 * pv + w2 * nx;
    }
}
__device__ __forceinline__ void load8f(const float* p, float (&f)[8]) {
    const f32x4 a = *(const f32x4*)p, b = *(const f32x4*)(p + 4);
    f[0] = a[0]; f[1] = a[1]; f[2] = a[2]; f[3] = a[3]; f[4] = b[0]; f[5] = b[1]; f[6] = b[2]; f[7] = b[3];
}
__device__ __forceinline__ void store8f(float* p, const float (&f)[8]) {
    *(f32x4*)p = (f32x4){f[0], f[1], f[2], f[3]}; *(f32x4*)(p + 4) = (f32x4){f[4], f[5], f[6], f[7]};
}
__device__ __forceinline__ const float* xin_row(PP P, int row) {
    return row < NPROMPT_ROWS ? P->in[0] + (size_t)row * D : P->in[1] + (size_t)(row - NPROMPT_ROWS) * D;
}

constexpr int BM = 256, BK = 64, HALF = 128, HTB = HALF * BK * 2, NXCD = 8, WGM = 8;
__device__ __forceinline__ int lds_byte(int r, int c) { const int st = (r >> 4) * 2 + (c >> 5), rr = r & 15, cc = c & 31, ob = rr * 64 + cc * 2; return st * 1024 + (ob ^ (((ob >> 9) & 1) << 5)); }
__device__ __forceinline__ void stage_rc(int b, int& R, int& C) { const int st = b / 1024, sb = b % 1024, swz = sb ^ (((sb >> 9) & 1) << 5); R = (st >> 1) * 16 + swz / 64; C = (st & 1) * 32 + (swz % 64) / 2; }
__device__ __forceinline__ int perm32(int rho) { const int n = rho >> 4, i = rho & 15; return 8 * (i >> 2) + 4 * n + (i & 3); }

struct Unit { int pm, pn; };
struct GemmD {
    const bf16_t* A; const bf16_t* Bt;
    int lda, ldb, K, nM, nN, tilesPerBatch;
    size_t bBatchStride;
};
struct StaticOrder {
    int nM, nN, nwg, G, c;
    __device__ void init(int nM_, int nN_, int G_, int c_) { nM = nM_; nN = nN_; nwg = nM * nN; G = G_; c = c_; }
    __device__ bool next(int i, Unit& u) const {
        const long L = (long)i * G + c; if (L >= nwg) return false;
        int wgid = (int)L; { const int q = nwg / NXCD, r = nwg % NXCD, xcd = wgid % NXCD, off = wgid / NXCD; wgid = (xcd < r ? xcd * (q + 1) : r * (q + 1) + (xcd - r) * q) + off; }
        const int nig = WGM * nN, gid = wgid / nig, fm = gid * WGM, gsz = (nM - fm) < WGM ? (nM - fm) : WGM;
        u.pm = fm + ((wgid % nig) % gsz); u.pn = (wgid % nig) / gsz; return true;
    }
};

struct EpiG {
    int kind; void* O; int ldc; int layer; int first; int wid; LAS unsigned char* lds;
    __device__ __forceinline__ bool perm() const { return kind != 1; }
    __device__ __forceinline__ void operator()(const f32x4 (&acc)[2][2][4][2], const Unit& u) const {
        PP P = (PP)__builtin_amdgcn_kernarg_segment_ptr(); asm volatile("" : "+s"(P));
        const int wr = wid >> 2, wc = wid & 3;
#define EPI_LANE() const int lane2 = fresh_lane(), fr = lane2 & 15, fq = lane2 >> 4
        if (kind == 0) {
            EPI_LANE();
            const int row0 = u.pm * BM + wr * 64 + fr, col0 = u.pn * BM + wc * 32 + 8 * fq;
#pragma unroll
            for (int ai = 0; ai < 2; ++ai)
#pragma unroll
                for (int m = 0; m < 4; ++m) {
                    bf16_t* rowp = (bf16_t*)O + (size_t)(row0 + ai * HALF + m * 16) * ldc + col0;
#pragma unroll
                    for (int bj = 0; bj < 2; ++bj) {
                        const f32x4 v0 = acc[ai][bj][m][0], v1 = acc[ai][bj][m][1];
                        u32x4 o; o[0] = cvt_pk_bf16(v0[0], v0[1]); o[1] = cvt_pk_bf16(v0[2], v0[3]); o[2] = cvt_pk_bf16(v1[0], v1[1]); o[3] = cvt_pk_bf16(v1[2], v1[3]);
                        *(u32x4*)(rowp + bj * HALF) = o;
                    }
                }
        } else if (kind == 1) {
            EPI_LANE();
            const int row0 = u.pm * BM + wr * 64 + fr, col0 = u.pn * BM + wc * 32 + 4 * fq;
#pragma unroll
            for (int ai = 0; ai < 2; ++ai)
#pragma unroll
                for (int m = 0; m < 4; ++m) {
                    float* rowp = (float*)O + (size_t)(row0 + ai * HALF + m * 16) * ldc + col0;
#pragma unroll
                    for (int bj = 0; bj < 2; ++bj)
#pragma unroll
                        for (int n = 0; n < 2; ++n) *(f32x4*)(rowp + bj * HALF + n * 16) = acc[ai][bj][m][n];
                }
        } else if (kind == 3) {
            EPI_LANE();
            const float* cw = P->in[24] + (size_t)layer * 3 * F2; const float* cb = P->in[25] + (size_t)layer * F2;
            bf16_t* eb = (bf16_t*)(P->ws + WS_EB);
            const int ch0 = u.pn * 128 + wc * 32 + 8 * fq;
            const float m0 = fr == 0 ? 1.f : 0.f, n0 = 1.f - m0, m15 = fr == 15 ? 1.f : 0.f, n15 = 1.f - m15;
            LAS unsigned char* wl = lds + LDS_CW + wid * 1024;
            { const int a_ = lane2 >> 3, q4 = (lane2 & 7) * 4;
              const float* src = (a_ < 6 ? cw + (a_ >> 1) * F2 : cb) + (a_ & 1) * F + (unsigned)(u.pn * 128 + wc * 32 + q4);
              const f32x4 wv = *(const f32x4*)src;
              *(LAS f32x4*)(wl + lane2 * 16) = wv; }
            asm volatile("s_waitcnt lgkmcnt(0)" ::: "memory");
#pragma unroll
            for (int ai = 0; ai < 2; ++ai) {
                const int rowb = u.pm * BM + ai * HALF + wr * 64, q = rowb >> 6;
                unsigned gq[4][4];
#pragma unroll
                for (int n = 0; n < 2; ++n) {
                    const int cc = ch0 + 4 * n;
                    f32x4 W[2][4];
#pragma unroll
                    for (int part = 0; part < 2; ++part)
#pragma unroll
                        for (int k = 0; k < 4; ++k) W[part][k] = *(const LAS f32x4*)(wl + (k * 2 + part) * 128 + (8 * fq + 4 * n) * 4);
                    unsigned pe[2][2][2];
#pragma unroll
                    for (int ep = 0; ep < 2; ++ep) {
                        f32x2 cres[2][4];
#pragma unroll
                        for (int part = 0; part < 2; ++part) {
                            const f32x2 w0 = (f32x2){W[part][0][2 * ep], W[part][0][2 * ep + 1]}, w1 = (f32x2){W[part][1][2 * ep], W[part][1][2 * ep + 1]};
                            const f32x2 w2 = (f32x2){W[part][2][2 * ep], W[part][2][2 * ep + 1]}, bb = (f32x2){W[part][3][2 * ep], W[part][3][2 * ep + 1]};
                            const f32x2 w0a = w0 * n0, w0b = w0 * m0, w2a = w2 * n15, w2b = w2 * m15;
                            f32x2 X[4], R[4], L[4];
#pragma unroll
                            for (int m = 0; m < 4; ++m) { X[m] = (f32x2){acc[ai][part][m][n][2 * ep], acc[ai][part][m][n][2 * ep + 1]};
                                R[m] = (f32x2){dpp_prev(X[m].x), dpp_prev(X[m].y)}; L[m] = (f32x2){dpp_next(X[m].x), dpp_next(X[m].y)}; }
#pragma unroll
                            for (int m = 0; m < 4; ++m) {
                                f32x2 c = X[m] * w1 + bb; c = R[m] * w0a + c; c = L[m] * w2a + c;
                                if (m > 0) c = R[m > 0 ? m - 1 : 0] * w0b + c;
                                if (m < 3) c = L[m < 3 ? m + 1 : 3] * w2b + c;
                                cres[part][m] = c;
                            }
                            pe[0][part][ep] = cvt_pk_bf16(cres[part][0].x, cres[part][0].y);
                            pe[1][part][ep] = cvt_pk_bf16(cres[part][3].x, cres[part][3].y);
                            __builtin_amdgcn_sched_barrier(0);
                        }
#pragma unroll
                        for (int m = 0; m < 4; ++m) {
                            const f32x2 a = cres[0][m], v = cres[1][m];
                            const f32x2 t = (a * a) * (-0.10294324f) + (-2.3022082f), z = a * t;
                            f32x2 d; d.x = __builtin_amdgcn_exp2f(z.x) + 1.f; d.y = __builtin_amdgcn_exp2f(z.y) + 1.f;
                            f32x2 r; r.x = __builtin_amdgcn_rcpf(d.x); r.y = __builtin_amdgcn_rcpf(d.y);
                            const f32x2 o = (a * v) * r;
                            gq[m][n * 2 + ep] = cvt_pk_bf16(o.x, o.y);
                        }
                        __builtin_amdgcn_sched_barrier(0);
                    }
                    if (fr == 0) { bf16_t* ep_ = eb + (unsigned)(((q * 2 + 0) * 2) * F2 + cc);
#pragma unroll
                        for (int part = 0; part < 2; ++part) {
                            *(u32x2*)(ep_ + (unsigned)(part * F)) = (u32x2){cvt_pk_bf16(acc[ai][part][0][n][0], acc[ai][part][0][n][1]), cvt_pk_bf16(acc[ai][part][0][n][2], acc[ai][part][0][n][3])};
                            *(u32x2*)(ep_ + (unsigned)(F2 + part * F)) = (u32x2){pe[0][part][0], pe[0][part][1]}; } }
                    if (fr == 15) { bf16_t* ep_ = eb + (unsigned)(((q * 2 + 1) * 2) * F2 + cc);
#pragma unroll
                        for (int part = 0; part < 2; ++part) {
                            *(u32x2*)(ep_ + (unsigned)(part * F)) = (u32x2){cvt_pk_bf16(acc[ai][part][3][n][0], acc[ai][part][3][n][1]), cvt_pk_bf16(acc[ai][part][3][n][2], acc[ai][part][3][n][3])};
                            *(u32x2*)(ep_ + (unsigned)(F2 + part * F)) = (u32x2){pe[1][part][0], pe[1][part][1]}; } }
                }
#pragma unroll
                for (int m = 0; m < 4; ++m) {
                    const bool edge = (m == 0 && fr == 0) || (m == 3 && fr == 15);
                    if (!edge) *(u32x4*)((bf16_t*)O + (unsigned)((rowb + m * 16 + fr) * F + ch0)) = (u32x4){gq[m][0], gq[m][1], gq[m][2], gq[m][3]};
                }
            }
        } else if (kind == 6) {
            EPI_LANE();
            if (u.pn < 8) {
                const int c0 = u.pn * 128 + wc * 32 + 8 * fq;
#pragma unroll
                for (int ai = 0; ai < 2; ++ai)
#pragma unroll
                    for (int m = 0; m < 4; ++m) {
                        const int row = u.pm * BM + ai * HALF + wr * 64 + m * 16 + fr;
                        float qv[8];
#pragma unroll
                        for (int e = 0; e < 8; ++e) qv[e] = acc[ai][0][m][e >> 2][e & 3] * acc[ai][1][m][e >> 2][e & 3];
                        *(u32x4*)((bf16_t*)O + (unsigned)(row * 2048 + c0)) = pack8(qv);
                    }
            } else {
                const int c0 = D + (u.pn - 8) * BM + wc * 32 + 8 * fq;
#pragma unroll
                for (int ai = 0; ai < 2; ++ai)
#pragma unroll
                    for (int m = 0; m < 4; ++m) {
                        const int row = u.pm * BM + ai * HALF + wr * 64 + m * 16 + fr;
#pragma unroll
                        for (int bj = 0; bj < 2; ++bj) {
                            float bv[8];
#pragma unroll
                            for (int e = 0; e < 8; ++e) bv[e] = acc[ai][bj][m][e >> 2][e & 3];
                            *(u32x4*)((bf16_t*)O + (unsigned)(row * 2048 + c0 + bj * HALF)) = pack8(bv);
                        }
                    }
            }
        } else if (kind == 5) {
            EPI_LANE();
            const int c0 = u.pn * 128 + wc * 32 + 8 * fq;
#pragma unroll
            for (int ai = 0; ai < 2; ++ai)
#pragma unroll
                for (int m = 0; m < 4; ++m) {
                    const int row = u.pm * BM + ai * HALF + wr * 64 + m * 16 + fr;
                    float mv[8];
#pragma unroll
                    for (int e = 0; e < 8; ++e) mv[e] = acc[ai][0][m][e >> 2][e & 3] * __builtin_amdgcn_rcpf(1.f + __builtin_amdgcn_exp2f(-1.4426950409f * acc[ai][1][m][e >> 2][e & 3]));
                    *(u32x4*)((bf16_t*)O + (unsigned)(row * D + c0)) = pack8(mv);
                }
        } else {
            EPI_LANE();
            const int row0 = u.pm * BM + wr * 64 + fr, col0 = u.pn * BM + wc * 32 + 8 * fq;
#pragma unroll
            for (int ai = 0; ai < 2; ++ai)
#pragma unroll
                for (int m = 0; m < 4; ++m) {
                    const int row = row0 + ai * HALF + m * 16, g = row / XR, r = row - g * XR;
#pragma unroll
                    for (int bj = 0; bj < 2; ++bj) {
                        const int col = col0 + bj * HALF, t = col >> 4, i0 = col & 15;
                        const f32x4 v0 = acc[ai][bj][m][0], v1 = acc[ai][bj][m][1];
                        u32x4 o; o[0] = cvt_pk_bf16(gelu_tanh(v0[0]), gelu_tanh(v0[1])); o[1] = cvt_pk_bf16(gelu_tanh(v0[2]), gelu_tanh(v0[3]));
                        o[2] = cvt_pk_bf16(gelu_tanh(v1[0]), gelu_tanh(v1[1])); o[3] = cvt_pk_bf16(gelu_tanh(v1[2]), gelu_tanh(v1[3]));
                        *(u32x4*)((bf16_t*)O + (size_t)(r * TCH + t) * D + g * 16 + i0) = o;
                    }
                }
        }
    }
};

__device__ __forceinline__ void gemm_phase(LAS unsigned char* lds, const GemmD& g, const EpiG& E) {
    const int wid = E.wid, tid = fresh_tid(wid), lane = tid & 63, wr = wid >> 2, wc = wid & 3, fr = lane & 15, fq = lane >> 4;
    const int K = g.K, nt = K / BK;
    StaticOrder S; S.init(g.nM, g.nN, gridDim.x, blockIdx.x);
    unsigned voffA[2], voffB[2];
#pragma unroll
    for (int i = 0; i < 2; ++i) { int R, C; stage_rc(tid * 16 + i * 8192, R, C); const int Rb = E.perm() ? ((R & ~31) + perm32(R & 31)) : R;
        voffA[i] = (unsigned)(R * g.lda + C) * 2u; voffB[i] = (unsigned)(Rb * g.ldb + C) * 2u; }
    const __amdgpu_buffer_rsrc_t rA = __builtin_amdgcn_make_buffer_rsrc((void*)g.A, (short)0, 0x7fffffff, 0x00020000);
    const __amdgpu_buffer_rsrc_t rB = __builtin_amdgcn_make_buffer_rsrc((void*)g.Bt, (short)0, 0x7fffffff, 0x00020000);
    const unsigned kstep = (unsigned)(BK * 2);
    const unsigned hstepA = (unsigned)HALF * g.lda * 2, hstepB = (unsigned)HALF * g.ldb * 2;
    const unsigned tstepA = 2 * hstepA, tstepB = 2 * hstepB;
    const unsigned ldsw = (unsigned)wid * 1024u;
    const int aoff = lds_byte(wr * 64 + fr, fq * 8), boff = lds_byte(wc * 32 + fr, fq * 8);
#define PG8_SA(b, h) (((b) * 2 + (h)) * HTB)
#define PG8_SB(b, h) ((4 + (b) * 2 + (h)) * HTB)
#define PG8_STAGE(bufoff, soff, R, voff) do { _Pragma("unroll") for (int _i = 0; _i < 2; ++_i) \
        __builtin_amdgcn_raw_ptr_buffer_load_lds(R, (LAS unsigned*)(lds + (bufoff) + ldsw + _i * 8192), 16, (int)(voff)[_i], (int)(soff), 0, 0); } while (0)
#define PG8_LDA(dst, b, h) do { _Pragma("unroll") for (int m = 0; m < 4; ++m) _Pragma("unroll") for (int k = 0; k < 2; ++k) dst[m][k] = *(const LAS bf16x8*)(lds + PG8_SA(b, h) + aoff + m * 2048 + k * 1024); } while (0)
#define PG8_LDB(dst, b, h) do { _Pragma("unroll") for (int n = 0; n < 2; ++n) _Pragma("unroll") for (int k = 0; k < 2; ++k) dst[n][k] = *(const LAS bf16x8*)(lds + PG8_SB(b, h) + boff + n * 2048 + k * 1024); } while (0)
#define PG8_MMA(ai, bj, At, Bt) do { __builtin_amdgcn_s_setprio(1); _Pragma("unroll") for (int m = 0; m < 4; ++m) _Pragma("unroll") for (int n = 0; n < 2; ++n) _Pragma("unroll") for (int k = 0; k < 2; ++k) \
        acc[ai][bj][m][n] = __builtin_amdgcn_mfma_f32_16x16x32_bf16(Bt[n][k], At[m][k], acc[ai][bj][m][n], 0, 0, 0); __builtin_amdgcn_s_setprio(0); } while (0)
#define PG8_WAIT_V(n) asm volatile("s_waitcnt vmcnt(" #n ")" ::: "memory")
#define PG8_WAIT_L(n) asm volatile("s_waitcnt lgkmcnt(" #n ")" ::: "memory")
#define PG8_BAR __builtin_amdgcn_s_barrier()
#define PG8_SCHED __builtin_amdgcn_sched_barrier(0)
    Unit cur, nxt; int ui = 0;
    if (!S.next(0, cur)) return;
    f32x4 acc[2][2][4][2];
#pragma unroll
    for (int a = 0; a < 2; ++a)
#pragma unroll
        for (int b = 0; b < 2; ++b)
#pragma unroll
            for (int m = 0; m < 4; ++m)
#pragma unroll
                for (int n = 0; n < 2; ++n) acc[a][b][m][n] = (f32x4){0.f, 0.f, 0.f, 0.f};
    bf16x8 At[4][2], B0[2][2], B1[2][2];
    unsigned cA = (unsigned)cur.pm * tstepA;
    unsigned cB = (unsigned)(((size_t)(cur.pm / g.tilesPerBatch) * g.bBatchStride) * 2) + (unsigned)cur.pn * tstepB;
    PG8_STAGE(PG8_SB(0, 0), cB, rB, voffB); PG8_STAGE(PG8_SA(0, 0), cA, rA, voffA); PG8_STAGE(PG8_SB(0, 1), cB + hstepB, rB, voffB); PG8_STAGE(PG8_SA(0, 1), cA + hstepA, rA, voffA);
    if (wr == 1) PG8_BAR;
    PG8_WAIT_V(4); PG8_BAR;
    PG8_STAGE(PG8_SB(1, 0), cB + kstep, rB, voffB); PG8_STAGE(PG8_SA(1, 0), cA + kstep, rA, voffA); PG8_STAGE(PG8_SB(1, 1), cB + hstepB + kstep, rB, voffB);
    PG8_WAIT_V(6); PG8_BAR;
    for (;;) {
        const bool has_next = S.next(ui + 1, nxt);
        const unsigned nA = has_next ? (unsigned)nxt.pm * tstepA : cA;
        const unsigned nB = has_next ? (unsigned)(((size_t)(nxt.pm / g.tilesPerBatch) * g.bBatchStride) * 2) + (unsigned)nxt.pn * tstepB : cB;
        for (int t = 0; t < nt; t += 2) {
            const bool last = (t == nt - 2);
            const unsigned a1 = cA + (unsigned)(t + 1) * kstep;
            const unsigned a2 = last ? nA : cA + (unsigned)(t + 2) * kstep; const unsigned b2 = last ? nB : cB + (unsigned)(t + 2) * kstep;
            const unsigned a3 = a2 + kstep; const unsigned b3 = b2 + kstep;
            PG8_LDB(B0, 0, 0); PG8_SCHED; PG8_LDA(At, 0, 0); PG8_STAGE(PG8_SA(1, 1), a1 + hstepA, rA, voffA);
            PG8_WAIT_L(8); PG8_BAR; PG8_WAIT_L(0); PG8_MMA(0, 0, At, B0); PG8_BAR; PG8_SCHED;
            PG8_LDB(B1, 0, 1); PG8_STAGE(PG8_SB(0, 0), b2, rB, voffB);
            PG8_BAR; PG8_WAIT_L(0); PG8_MMA(0, 1, At, B1); PG8_BAR;
            PG8_LDA(At, 0, 1); PG8_STAGE(PG8_SA(0, 0), a2, rA, voffA);
            PG8_BAR; PG8_WAIT_L(0); PG8_MMA(1, 0, At, B0); PG8_BAR; PG8_SCHED;
            PG8_STAGE(PG8_SB(0, 1), b2 + hstepB, rB, voffB);
            PG8_WAIT_V(6); PG8_BAR; PG8_MMA(1, 1, At, B1); PG8_BAR;
            PG8_LDB(B0, 1, 0); PG8_SCHED; PG8_LDA(At, 1, 0); PG8_STAGE(PG8_SA(0, 1), a2 + hstepA, rA, voffA);
            PG8_WAIT_L(8); PG8_BAR; PG8_WAIT_L(0); PG8_MMA(0, 0, At, B0); PG8_BAR; PG8_SCHED;
            PG8_LDB(B1, 1, 1); PG8_STAGE(PG8_SB(1, 0), b3, rB, voffB);
            PG8_BAR; PG8_WAIT_L(0); PG8_MMA(0, 1, At, B1); PG8_BAR;
            PG8_LDA(At, 1, 1); PG8_STAGE(PG8_SA(1, 0), a3, rA, voffA);
            PG8_BAR; PG8_WAIT_L(0); PG8_MMA(1, 0, At, B0); PG8_BAR; PG8_SCHED;
            PG8_STAGE(PG8_SB(1, 1), b3 + hstepB, rB, voffB);
            PG8_WAIT_V(6); PG8_BAR; PG8_MMA(1, 1, At, B1); PG8_BAR;
        }
        E(acc, cur);
        if (!has_next) break;
#pragma unroll
        for (int a = 0; a < 2; ++a)
#pragma unroll
            for (int b = 0; b < 2; ++b)
#pragma unroll
                for (int m = 0; m < 4; ++m)
#pragma unroll
                    for (int n = 0; n < 2; ++n) acc[a][b][m][n] = (f32x4){0.f, 0.f, 0.f, 0.f};
        cur = nxt; cA = nA; cB = nB; ++ui;
    }
    PG8_WAIT_V(0);
    if (wr == 0) PG8_BAR;
    PG8_BAR;
#undef PG8_SA
#undef PG8_SB
#undef PG8_STAGE
#undef PG8_LDA
#undef PG8_LDB
#undef PG8_MMA
#undef PG8_WAIT_V
#undef PG8_WAIT_L
#undef PG8_BAR
#undef PG8_SCHED
}

__device__ __forceinline__ void transpose_tile4(int wid, LAS float* tile, const float* src, bf16_t* dst, int K, int N, int k0, int nt4, int pair) {
    const int t = fresh_tid(wid);
    { const int row = t >> 3, c8 = (t & 7) * 8;
#pragma unroll
      for (int q = 0; q < 4; ++q) { const int nt = nt4 * 4 + q, n0src = pair > 0 ? ((nt >> 1) & 1) * pair + (nt >> 2) * 128 + (nt & 1) * 64 : pair < 0 ? (nt < 32 ? D + ((nt >> 1) & 1) * D + (nt >> 2) * 128 + (nt & 1) * 64 : (nt - 32) * 64) : nt * 64;
          float f[8]; load8f(src + (size_t)(k0 + row) * N + n0src + c8, f);
#pragma unroll
          for (int e = 0; e < 8; ++e) tile[q * 4160 + row * 65 + c8 + e] = f[e]; } }
    __syncthreads();
    { const int n = t >> 3, k8 = (t & 7) * 8;
#pragma unroll
      for (int q = 0; q < 4; ++q) { float f[8];
#pragma unroll
          for (int e = 0; e < 8; ++e) f[e] = tile[q * 4160 + (k8 + e) * 65 + n];
          *(u32x4*)(dst + (size_t)(nt4 * 256 + q * 64 + n) * K + k0 + k8) = pack8(f); } }
    __syncthreads();
}

constexpr int NT_WIN = 2 * 16 * 12, NT_WOUT = 2 * 16 * 4, NT_WGLU = 2 * 16 * 8, NT_WUP = 4 * 16 * 22, NT_WDN = 4 * 44 * 4;
constexpr int IT_ADA = DEPTH * (6 * D / 128);
constexpr int IT_S5 = 2 * NG * 2;
constexpr int IT_TR0 = IT_ADA + IT_S5;
constexpr int IT_TOTAL = IT_TR0 + NT_WIN + NT_WOUT + NT_WGLU + NT_WUP + NT_WDN;

__device__ void phase0_item(PP P, int wid, LAS unsigned char* lds, int item) {
    const int tid = fresh_tid(wid);
    if (item < IT_ADA) {
        const int layer = item / 48, nb = item % 48, col = nb * 128 + (tid & 127), bg = tid >> 7;
        LAS float* cs = (LAS float*)lds;
        const float* W = P->in[4] + (size_t)layer * D * 6 * D;
        float acc[10];
#pragma unroll
        for (int i = 0; i < 10; ++i) acc[i] = 0.f;
        for (int kc = 0; kc < 4; ++kc) {
            __syncthreads();
            for (int e = tid; e < 40 * 256; e += NTHREADS) { const int b = e >> 8, k = kc * 256 + (e & 255);
                const float c = b < 32 ? P->in[2][b * D + k] : P->in[3][(b - 32) * D + k]; cs[e] = c / (1.f + __expf(-c)); }
            __syncthreads();
            for (int k = 0; k < 256; k += 4) {
                const float* wp = W + (size_t)(kc * 256 + k) * (6 * D) + col;
                const float w0 = wp[0], w1 = wp[6 * D], w2 = wp[2 * 6 * D], w3 = wp[3 * 6 * D];
#pragma unroll
                for (int i = 0; i < 10; ++i) { const f32x4 c4 = *(const LAS f32x4*)(cs + (bg * 10 + i) * 256 + k); acc[i] += c4[0] * w0 + c4[1] * w1 + c4[2] * w2 + c4[3] * w3; } }
        }
        const float bias = P->in[5][layer * 6 * D + col];
        float* mod = (float*)(P->ws + WS_MOD);
#pragma unroll
        for (int i = 0; i < 10; ++i) mod[((size_t)layer * NSEQ + bg * 10 + i) * (6 * D) + col] = acc[i] + bias;
        __syncthreads();
        return;
    }
    item -= IT_ADA;
    if (item < IT_S5) {
        const int j = item >> 7, g = (item >> 1) & 63, k = item & 1;
        LAS float* pwr = (LAS float*)lds;
        LAS float* pwi = pwr + 33 * 64;
        LAS float* Cre = pwi + 33 * 64;
        LAS float* Cim = Cre + 16 * 64;
        LAS float* Bbr = Cim + 16 * 64;
        LAS float* Bbi = Bbr + 64 * 16;
        const size_t pbase = ((size_t)(j * 2 + k) * NG + g);
        const float dt = expf(P->in[16][pbase]);
        __syncthreads();
        for (int e = tid; e < 33 * 64; e += NTHREADS) { const int tau = e >> 6, p = e & 63;
            const float lr = P->in[14][pbase * 64 + p], li = P->in[15][pbase * 64 + p];
            const float mag = expf(lr * dt * (float)tau), ang = li * dt * (float)tau;
            pwr[e] = mag * cosf(ang); pwi[e] = mag * sinf(ang); }
        for (int e = tid; e < 1024; e += NTHREADS) { Cre[e] = P->in[19][pbase * 1024 + e]; Cim[e] = P->in[20][pbase * 1024 + e]; }
        __syncthreads();
        for (int e = tid; e < 1024; e += NTHREADS) { const int p = e >> 4;
            const float lr = P->in[14][pbase * 64 + p], li = P->in[15][pbase * 64 + p];
            const float lbr = pwr[64 + p], lbi = pwi[64 + p], den = lr * lr + li * li;
            const float fr_ = ((lbr - 1.f) * lr + lbi * li) / den, fi_ = (lbi * lr - (lbr - 1.f) * li) / den;
            const float br = P->in[17][pbase * 1024 + e], bi = P->in[18][pbase * 1024 + e];
            Bbr[e] = fr_ * br - fi_ * bi; Bbi[e] = fr_ * bi + fi_ * br; }
        __syncthreads();
        float* kt = (float*)(P->ws + WS_KTAB) + ((size_t)(j * NG + g) * 2 + k) * 32 * 256;
        { const int tau = tid >> 4, i = tid & 15;
            float sacc[16];
#pragma unroll
            for (int jj = 0; jj < 16; ++jj) sacc[jj] = 0.f;
            for (int p = 0; p < 64; ++p) { const float cr = Cre[i * 64 + p], ci = Cim[i * 64 + p], pr = pwr[tau * 64 + p], pi = pwi[tau * 64 + p];
                const float xr = cr * pr - ci * pi, xi = cr * pi + ci * pr;
#pragma unroll
                for (int j4 = 0; j4 < 4; ++j4) { const f32x4 br = *(const LAS f32x4*)(Bbr + p * 16 + j4 * 4), bi = *(const LAS f32x4*)(Bbi + p * 16 + j4 * 4);
#pragma unroll
                    for (int q = 0; q < 4; ++q) sacc[j4 * 4 + q] += xr * br[q] - xi * bi[q]; } }
#pragma unroll
            for (int j4 = 0; j4 < 4; ++j4) *(f32x4*)(kt + tau * 256 + i * 16 + j4 * 4) = (f32x4){sacc[j4 * 4], sacc[j4 * 4 + 1], sacc[j4 * 4 + 2], sacc[j4 * 4 + 3]}; }
        bf16_t* em = (bf16_t*)(P->ws + WS_EMAT) + ((size_t)(j * NG + g) * 256 + k * 128) * 512;
        for (int e = tid; e < 128 * 64; e += NTHREADS) { const int n = e >> 6, kk8 = (e & 63) * 8, p = n & 63, im = n >> 6, s = kk8 >> 4, j0 = kk8 & 15;
            const int pw_e = k == 0 ? (TCH - 1 - s) : s; const float pr = pwr[pw_e * 64 + p], pi = pwi[pw_e * 64 + p]; float f[8];
#pragma unroll
            for (int q = 0; q < 8; ++q) { const float br = Bbr[p * 16 + j0 + q], bi = Bbi[p * 16 + j0 + q]; f[q] = im ? (pr * bi + pi * br) : (pr * br - pi * bi); }
            *(u32x4*)(em + (size_t)n * 512 + kk8) = pack8(f); }
        bf16_t* ym = (bf16_t*)(P->ws + WS_YMAT) + (size_t)(j * NG + g) * 512 * XLD + 512 + k * 128;
        for (int e = tid; e < 512 * 16; e += NTHREADS) { const int n = e >> 4, c8 = (e & 15) * 8, t = n >> 4, i = n & 15, im = c8 >> 6, p0 = c8 & 63;
            const int pw_e = k == 0 ? (t + 1) : (TCH - t); float f[8];
#pragma unroll
            for (int q = 0; q < 8; ++q) { const int p = p0 + q; const float cr = Cre[i * 64 + p], ci = Cim[i * 64 + p], pr = pwr[pw_e * 64 + p], pi = pwi[pw_e * 64 + p];
                f[q] = im ? -(cr * pi + ci * pr) : (cr * pr - ci * pi); }
            *(u32x4*)(ym + (size_t)n * XLD + c8) = pack8(f); }
        __syncthreads();
        return;
    }
    item -= IT_S5;
    LAS float* tile = (LAS float*)lds;
    if (item < NT_WIN) { const int l = item / 192, r = item % 192, kt = r / 12, nt4 = r % 12;
        transpose_tile4(wid, tile, P->in[10] + (size_t)l * D * 3072, (bf16_t*)(P->ws + WS_WIN + l * SZ_WIN), D, 3072, kt * 64, nt4, -1); return; }
    item -= NT_WIN;
    if (item < NT_WOUT) { const int l = item / 64, r = item % 64, kt = r / 4, nt4 = r % 4;
        transpose_tile4(wid, tile, P->in[13] + (size_t)l * D * D, (bf16_t*)(P->ws + WS_WOUT + l * SZ_WOUT), D, D, kt * 64, nt4, 0); return; }
    item -= NT_WOUT;
    if (item < NT_WGLU) { const int l = item / 128, r = item % 128, kt = r / 8, nt4 = r % 8;
        transpose_tile4(wid, tile, P->in[22] + (size_t)l * D * 2048, (bf16_t*)(P->ws + WS_WGLU + l * SZ_WGLU), D, 2048, kt * 64, nt4, D); return; }
    item -= NT_WGLU;
    if (item < NT_WUP) { const int l = item / 352, r = item % 352, kt = r / 22, nt4 = r % 22;
        transpose_tile4(wid, tile, P->in[23] + (size_t)l * D * F2, (bf16_t*)(P->ws + WS_WUP + l * SZ_WUP), D, F2, kt * 64, nt4, F); return; }
    item -= NT_WUP;
    { const int l = item / 176, r = item % 176, kt = r / 4, nt4 = r % 4;
        transpose_tile4(wid, tile, P->in[26] + (size_t)l * F * D, (bf16_t*)(P->ws + WS_WDN + l * SZ_WDN), F, D, kt * 64, nt4, 0); }
}

__device__ void phase_ymat_toeplitz(PP P, int wid) {
    const int tidx = fresh_tid(wid);
    const size_t total = (size_t)2 * NG * 512 * 64;
    const float* ktab = (const float*)(P->ws + WS_KTAB);
    for (size_t it = (size_t)blockIdx.x * NTHREADS + tidx; it < total; it += (size_t)gridDim.x * NTHREADS) {
        const int k8 = (int)(it & 63) * 8, n = (int)(it >> 6) & 511, jg = (int)(it >> 15);
        const int t = n >> 4, i = n & 15, s = k8 >> 4, j0 = k8 & 15;
        const float* kf = ktab + ((size_t)jg * 2 + 0) * 32 * 256, *kb = ktab + ((size_t)jg * 2 + 1) * 32 * 256;
        float f[8];
        if (s < t) { load8f(kf + (t - s) * 256 + i * 16 + j0, f); }
        else if (s > t) { load8f(kb + (s - t) * 256 + i * 16 + j0, f); }
        else { float a[8], b[8]; load8f(kf + i * 16 + j0, a); load8f(kb + i * 16 + j0, b);
            const int j = jg >> 6, g = jg & 63; const float dsk = P->in[21][j * D + g * 16 + i];
#pragma unroll
            for (int q = 0; q < 8; ++q) f[q] = a[q] + b[q] + ((j0 + q) == i ? dsk : 0.f); }
        *(u32x4*)((bf16_t*)(P->ws + WS_YMAT) + ((size_t)jg * 512 + n) * XLD + k8) = pack8(f);
    }
}

__device__ __forceinline__ void store_A(bf16_t* A, bool xlayout, int token, int c8, const float (&u)[8]) {
    if (!xlayout) *(u32x4*)(A + (size_t)token * D + c8) = pack8(u);
    else { const int g = c8 >> 4, i0 = c8 & 15, r = token >> 5, t = token & 31; *(u32x4*)(A + ((size_t)g * XR + r) * XLD + t * 16 + i0) = pack8(u); }
}

__device__ __forceinline__ void load_A(const bf16_t* A, bool xlayout, int token, int c8, float (&u)[8]) {
    if (!xlayout) unpack8(*(const u32x4*)(A + (size_t)token * D + c8), u);
    else { const int g = c8 >> 4, i0 = c8 & 15, r = token >> 5, t = token & 31; unpack8(*(const u32x4*)(A + ((size_t)g * XR + r) * XLD + t * 16 + i0), u); }
}

__device__ void phase_modulate0(PP P, int wid) {
    const int tidx = fresh_tid(wid);
    const float* mod = (const float*)(P->ws + WS_MOD);
    bf16_t* A = (bf16_t*)(P->ws + WS_A);
    for (size_t it = (size_t)blockIdx.x * NTHREADS + tidx; it < (size_t)MT * 128; it += (size_t)gridDim.x * NTHREADS) {
        const int token = (int)(it >> 7), c8 = (int)(it & 127) * 8, seq = token >> 11;
        float x[8], sh[8], sc[8], u[8];
        load8f(xin_row(P, token) + c8, x);
        const float* mrow = mod + (size_t)(0 * NSEQ + seq) * 6 * D;
        load8f(mrow + c8, sh); load8f(mrow + D + c8, sc);
#pragma unroll
        for (int e = 0; e < 8; ++e) u[e] = x[e] * (1.f + sc[e]) + sh[e];
        store_A(A, false, token, c8, u);
    }
}

__device__ void phase_resid_ln(PP P, int wid, int layer, int sub, const bf16_t* usrc, const bf16_t* msrc, bf16_t* Adst) {
    const int tidx = fresh_tid(wid);
    const float* mod = (const float*)(P->ws + WS_MOD);
    const int wv = tidx >> 6, lane = tidx & 63;
    const float* lng = P->in[sub == 0 ? 6 : 8] + layer * D, *lnb = P->in[sub == 0 ? 7 : 9] + layer * D;
    const int nl = sub == 0 ? layer : layer + 1, nsub = sub == 0 ? 1 : 0;
    const bool has_next = nl < DEPTH, xlayout = has_next && nsub == 0 && (nl & 1), x_from_input = layer == 0 && sub == 0;
    const bool src_xlayout = sub == 0 && (layer & 1);
    const int rpw = (MT + (int)gridDim.x - 1) / (int)gridDim.x, rbeg = blockIdx.x * rpw, rend = (rbeg + rpw) < MT ? (rbeg + rpw) : MT;
    float gm[16], bt[16], gt[16], sh[16], sc[16], nsh[16], nsc[16];
#pragma unroll
    for (int h = 0; h < 2; ++h) { float t[8]; load8f(lng + h * 512 + lane * 8, t);
#pragma unroll
        for (int e = 0; e < 8; ++e) gm[h * 8 + e] = t[e];
        load8f(lnb + h * 512 + lane * 8, t);
#pragma unroll
        for (int e = 0; e < 8; ++e) bt[h * 8 + e] = t[e]; }
    int cur_seq = -1;
    for (int row = rbeg + wv; row < rend; row += 16) {
        const int seq = row >> 11;
        if (seq != cur_seq) {
            cur_seq = seq;
            const float* mrow = mod + (size_t)(layer * NSEQ + seq) * 6 * D;
            const float* nmrow = mod + (size_t)((has_next ? nl : 0) * NSEQ + seq) * 6 * D;
#pragma unroll
            for (int h = 0; h < 2; ++h) { const int c8 = h * 512 + lane * 8; float t[8];
                load8f(mrow + (sub == 0 ? 2 : 5) * D + c8, t);
#pragma unroll
                for (int e = 0; e < 8; ++e) gt[h * 8 + e] = 1.f + t[e];
                load8f(mrow + (sub == 0 ? 0 : 3) * D + c8, t);
#pragma unroll
                for (int e = 0; e < 8; ++e) sh[h * 8 + e] = t[e];
                load8f(mrow + (sub == 0 ? 1 : 4) * D + c8, t);
#pragma unroll
                for (int e = 0; e < 8; ++e) sc[h * 8 + e] = __builtin_amdgcn_rcpf(1.f + t[e]);
                load8f(nmrow + (nsub == 0 ? 0 : 3) * D + c8, t);
#pragma unroll
                for (int e = 0; e < 8; ++e) nsh[h * 8 + e] = t[e];
                load8f(nmrow + (nsub == 0 ? 1 : 4) * D + c8, t);
#pragma unroll
                for (int e = 0; e < 8; ++e) nsc[h * 8 + e] = 1.f + t[e]; }
        }
        const int row2 = row + 8;
        const int nr = (row2 < rend && (row2 >> 11) == seq) ? 2 : 1;
        float y[2][16], sum[2] = {0.f, 0.f}, sq[2] = {0.f, 0.f};
#pragma unroll
        for (int rr = 0; rr < 2; ++rr) {
            if (rr < nr) {
                const int r = row + rr * 8;
#pragma unroll
                for (int h = 0; h < 2; ++h) {
                    const int c8 = h * 512 + lane * 8; float x[8], m[8];
                    if (x_from_input) load8f(xin_row(P, r) + c8, x);
                    else { float u[8]; load_A(usrc, src_xlayout, r, c8, u);
#pragma unroll
                        for (int e = 0; e < 8; ++e) x[e] = (u[e] - sh[h * 8 + e]) * sc[h * 8 + e]; }
                    unpack8(*(const u32x4*)(msrc + (size_t)r * D + c8), m);
#pragma unroll
                    for (int e = 0; e < 8; ++e) { const float v = ALPHA * x[e] + gt[h * 8 + e] * m[e]; y[rr][h * 8 + e] = v; sum[rr] += v; sq[rr] += v * v; }
                }
            }
        }
#pragma unroll
        for (int rr = 0; rr < 2; ++rr) {
            if (rr < nr) {
                const int r = row + rr * 8;
                const float ts = wave_sum_dpp(sum[rr]), tq = wave_sum_dpp(sq[rr]);
                const float mu = ts * (1.f / D), var = fmaxf(tq * (1.f / D) - mu * mu, 0.f), rstd = rsqrtf(var + LN_EPS);
#pragma unroll
                for (int h = 0; h < 2; ++h) {
                    const int c8 = h * 512 + lane * 8; float xn[8];
#pragma unroll
                    for (int e = 0; e < 8; ++e) xn[e] = (y[rr][h * 8 + e] - mu) * rstd * gm[h * 8 + e] + bt[h * 8 + e];
                    if (has_next) { float u[8];
#pragma unroll
                        for (int e = 0; e < 8; ++e) u[e] = xn[e] * nsc[h * 8 + e] + nsh[h * 8 + e];
                        store_A(Adst, xlayout, r, c8, u); }
                    else store8f(P->out + (size_t)r * D + c8, xn);
                }
            }
        }
        if (nr == 1 && row2 < rend) row -= 8;
    }
}

constexpr int CG_ROWS = 40;
__device__ void phase_convgate(PP P, int wid, int j) {
    const int tidx = fresh_tid(wid);
    const bf16_t* Pb = (const bf16_t*)(P->ws + WS_BIG);
    bf16_t* A = (bf16_t*)P->out;
    const float* cw = P->in[11] + (size_t)j * 3 * D, *cb = P->in[12] + (size_t)j * D;
    const int wv = tidx >> 6, lane = tidx & 63;
    const int nunits = (MT / CG_ROWS) * 2;
    for (int unit = blockIdx.x * 8 + wv; unit < nunits; unit += gridDim.x * 8) {
        const int half = unit & 1, t0 = (unit >> 1) * CG_ROWS, c8 = half * 512 + lane * 8;
        float w0[8], w1[8], w2[8], bb[8], qp[8], qc[8], qn[8];
        load8f(cw + c8, w0); load8f(cw + D + c8, w1); load8f(cw + 2 * D + c8, w2); load8f(cb + c8, bb);
        const bf16_t* row = Pb + (size_t)t0 * 2048 + c8;
        if (t0 > 0) unpack8(*(const u32x4*)(row - 2048), qp);
        else {
#pragma unroll
            for (int e = 0; e < 8; ++e) qp[e] = 0.f; }
        unpack8(*(const u32x4*)(row), qc);
        for (int i = 0; i < CG_ROWS; ++i, row += 2048) {
            const int l = (t0 + i) & (SEQL - 1);
            float bg[8], o[8];
            unpack8(*(const u32x4*)(row + D), bg);
            if (t0 + i + 1 < MT) unpack8(*(const u32x4*)(row + 2048), qn);
            else {
#pragma unroll
                for (int e = 0; e < 8; ++e) qn[e] = 0.f; }
            const float mp = l > 0 ? 1.f : 0.f, mn = l < SEQL - 1 ? 1.f : 0.f;
#pragma unroll
            for (int e = 0; e < 8; ++e) { o[e] = bg[e] * (bb[e] + w0[e] * (mp * qp[e]) + w1[e] * qc[e] + w2[e] * (mn * qn[e])); qp[e] = qc[e]; qc[e] = qn[e]; }
            *(u32x4*)(A + (size_t)(t0 + i) * D + c8) = pack8(o);
        }
    }
}

__device__ void phase_ffn_fix(PP P, int wid, int layer) {
    const int tidx = fresh_tid(wid);
    const bf16_t* eb = (const bf16_t*)(P->ws + WS_EB);
    bf16_t* G = (bf16_t*)(P->ws + WS_BIG);
    const float* cw = P->in[24] + (size_t)layer * 3 * F2;
    for (int it = blockIdx.x * NTHREADS + tidx; it < NQ * 2 * 352; it += gridDim.x * NTHREADS) {
        const int c8 = (it % 352) * 8, qs = it / 352, q = qs >> 1, sd = qs & 1;
        const int row = q * 64 + (sd ? 63 : 0), l = row & (SEQL - 1);
        const bf16_t* me = eb + ((size_t)(q * 2 + sd) * 2 + 1) * F2;
        float pa[8], pv[8];
        unpack8(*(const u32x4*)(me + c8), pa); unpack8(*(const u32x4*)(me + F + c8), pv);
        const bool has_nb = sd ? (l < SEQL - 1) : (l > 0);
        if (has_nb) {
            const bf16_t* nb = eb + ((size_t)((sd ? q + 1 : q - 1) * 2 + (sd ? 0 : 1)) * 2 + 0) * F2;
            float ra[8], rv[8], wa[8], wv[8];
            unpack8(*(const u32x4*)(nb + c8), ra); unpack8(*(const u32x4*)(nb + F + c8), rv);
            load8f(cw + (sd ? 2 : 0) * F2 + c8, wa); load8f(cw + (sd ? 2 : 0) * F2 + F + c8, wv);
#pragma unroll
            for (int e = 0; e < 8; ++e) { pa[e] += wa[e] * ra[e]; pv[e] += wv[e] * rv[e]; }
        }
        float o[8];
#pragma unroll
        for (int e = 0; e < 8; ++e) o[e] = gelu_tanh(pa[e]) * pv[e];
        *(u32x4*)(G + (size_t)row * F + c8) = pack8(o);
    }
}

__device__ __forceinline__ void scan_thread(PP P, int j, int seq, int g, int k, int p) {
    const bf16_t* E = (const bf16_t*)(P->ws + WS_A);
    bf16_t* X = (bf16_t*)(P->ws + WS_BIG);
    const size_t pbase = ((size_t)(j * 2 + k) * NG + g);
    const float dt = expf(P->in[16][pbase]);
    const float lr = P->in[14][pbase * 64 + p], li = P->in[15][pbase * 64 + p];
    const float mag = expf(lr * dt * (float)TCH), ang = li * dt * (float)TCH;
    const float ar = mag * cosf(ang), ai = mag * sinf(ang);
    float sr = 0.f, si = 0.f;
    const size_t rbase = (size_t)g * XR + (size_t)seq * NCHUNK;
    for (int cb = 0; cb < NCHUNK; cb += 8) {
        float er[8], ei[8];
#pragma unroll
        for (int q = 0; q < 8; ++q) { const int c = k == 0 ? cb + q : NCHUNK - 1 - (cb + q); const size_t r = rbase + c;
            er[q] = __uint_as_float((unsigned)E[r * 256 + k * 128 + p] << 16); ei[q] = __uint_as_float((unsigned)E[r * 256 + k * 128 + 64 + p] << 16); }
#pragma unroll
        for (int q = 0; q < 8; ++q) { const int c = k == 0 ? cb + q : NCHUNK - 1 - (cb + q); const size_t r = rbase + c;
            X[r * XLD + 512 + k * 128 + p] = (bf16_t)(cvt_pk_bf16(sr, 0.f) & 0xffffu);
            X[r * XLD + 512 + k * 128 + 64 + p] = (bf16_t)(cvt_pk_bf16(si, 0.f) & 0xffffu);
            const float nr = ar * sr - ai * si + er[q], ni = ar * si + ai * sr + ei[q];
            sr = nr; si = ni; }
    }
}
__device__ void phase_scan_local(PP P, int wid, int j) {
    const int tidx = fresh_tid(wid);
    StaticOrder S; S.init(NG * XR / BM, 1, gridDim.x, blockIdx.x);
    Unit u;
    for (int i = 0; S.next(i, u); ++i) {
        const int g = u.pm / (XR / BM), pml = u.pm - g * (XR / BM);
        scan_thread(P, j, pml * 4 + (tidx >> 7), g, (tidx >> 6) & 1, tidx & 63);
    }
}

#define XB_TMO      128
#define XB_XCNT(j)  (256  + 64 * (j))
#define XB_XSUB(j)  (1280 + 64 * (j))
#define XB_XGEN(j)  (2304 + 64 * (j))
#define XB_TOP      3328
#define XB_TOPGEN   3392
#define XCD_BAR_WORDS 3456
#define XB_SPIN_CAP (1u << 18)
__device__ __forceinline__ unsigned xb_ld(unsigned* p)              { return __hip_atomic_load(p, __ATOMIC_RELAXED, __HIP_MEMORY_SCOPE_AGENT); }
__device__ __forceinline__ unsigned xb_add(unsigned* p, unsigned v) { return __hip_atomic_fetch_add(p, v, __ATOMIC_RELAXED, __HIP_MEMORY_SCOPE_AGENT); }
__device__ __forceinline__ unsigned xb_xcc_id() { return (unsigned)__builtin_amdgcn_s_getreg((3 << 11) | 20) & 0xFu; }
#define XB_SPIN(cond, bar) do { unsigned _sp = 0; while (cond) { __builtin_amdgcn_s_sleep(1); \
    if ((++_sp & 255u) == 0u) { if (xb_ld(&(bar)[XB_TMO])) break; if (_sp > XB_SPIN_CAP) { atomicAdd(&(bar)[XB_TMO], 1u); break; } } } } while (0)
struct XcdBarrier { unsigned* bar; unsigned x; volatile LAS unsigned* st; };
__device__ __forceinline__ XcdBarrier xcd_barrier_post(unsigned* bar, volatile LAS unsigned* st) {
    XcdBarrier b; b.bar = bar; b.x = xb_xcc_id(); b.st = st;
    if (threadIdx.x == 0) (void)xb_add(&bar[XB_XCNT(b.x)], 1u);
    return b;
}
__device__ __forceinline__ void xcd_barrier_complete(unsigned* bar, unsigned x, unsigned& nloc, unsigned& nx) {
    const unsigned G = gridDim.x * gridDim.y * gridDim.z;
    unsigned sum, cnt, mine, sp = 0u;
    for (;;) {
        sum = 0u; cnt = 0u; mine = 0u;
#pragma unroll
        for (unsigned j = 0; j < 16; ++j) { const unsigned c = xb_ld(&bar[XB_XCNT(j)]); sum += c; cnt += (c > 0u) ? 1u : 0u; mine = (j == x) ? c : mine; }
        if (sum == G) break;
        __builtin_amdgcn_s_sleep(1);
        if ((++sp & 255u) == 0u) { if (xb_ld(&bar[XB_TMO])) break; if (sp > XB_SPIN_CAP) { atomicAdd(&bar[XB_TMO], 1u); break; } }
    }
    nloc = mine > 0u ? mine : 1u; nx = cnt > 0u ? cnt : 1u;
}
__device__ __forceinline__ void xcd_barrier(int wid, LAS unsigned char* lds) {
    asm volatile("s_waitcnt vmcnt(0)" ::: "memory");
    __syncthreads();
    if (wid == 0 && fresh_lane() == 0) {
        PP P = (PP)__builtin_amdgcn_kernarg_segment_ptr(); asm volatile("" : "+s"(P));
        XcdBarrier b; b.bar = (unsigned*)(P->ws + WS_BAR); b.x = xb_xcc_id(); b.st = (volatile LAS unsigned*)(lds + LDS_STAGE);
        unsigned* bar = b.bar;
        __builtin_amdgcn_s_waitcnt(0);
        unsigned nloc = b.st[0], nx = b.st[1];
        if (nloc == 0u) { xcd_barrier_complete(bar, b.x, nloc, nx); b.st[0] = nloc; b.st[1] = nx; }
        const unsigned old = xb_add(&bar[XB_XSUB(b.x)], 1u);
        const unsigned gen = old / nloc;
        if (old + 1u == (gen + 1u) * nloc) {
            __builtin_amdgcn_fence(__ATOMIC_RELEASE, "agent");
            asm volatile("s_waitcnt vmcnt(0)" ::: "memory");
            const unsigned og = xb_add(&bar[XB_TOP], 1u);
            const unsigned tg = og / nx;
            if (og + 1u == (tg + 1u) * nx) xb_add(&bar[XB_TOPGEN], 1u);
            else XB_SPIN(xb_ld(&bar[XB_TOPGEN]) == tg, bar);
            __builtin_amdgcn_fence(__ATOMIC_ACQUIRE, "agent");
            xb_add(&bar[XB_XGEN(b.x)], 1u);
            asm volatile("s_waitcnt vmcnt(0)" ::: "memory");
        } else {
            XB_SPIN(xb_ld(&bar[XB_XGEN(b.x)]) == gen, bar);
            __builtin_amdgcn_fence(__ATOMIC_ACQUIRE, "agent");
            asm volatile("s_waitcnt vmcnt(0)" ::: "memory");
        }
    }
    __syncthreads();
}

#define PROBE 0
__global__ void __launch_bounds__(NTHREADS, 2) fwd_megakernel(Params Parg) {
    extern __shared__ __attribute__((aligned(16))) unsigned char lds_raw[];
    LAS unsigned char* lds = (LAS unsigned char*)lds_raw;
    cg::grid_group grid = cg::this_grid();
    const int wid = __builtin_amdgcn_readfirstlane((int)threadIdx.x >> 6);
    volatile LAS unsigned* xb_st = (volatile LAS unsigned*)(lds + LDS_STAGE);
    if (threadIdx.x == 0) { xb_st[0] = 0u; xb_st[1] = 0u; xb_st[2] = 0u; xb_st[3] = 0u; }
    __syncthreads();
    { PP P0 = (PP)__builtin_amdgcn_kernarg_segment_ptr(); (void)xcd_barrier_post((unsigned*)(P0->ws + WS_BAR), xb_st); }
    {
        PP P = (PP)__builtin_amdgcn_kernarg_segment_ptr(); asm volatile("" : "+s"(P));
        for (int rep = 0; rep < (PROBE == 6 ? 2 : 1); ++rep)
        for (int item = blockIdx.x; item < IT_TOTAL; item += gridDim.x) phase0_item(P, wid, lds, item);
    }
    grid.sync();
    {
        PP P = (PP)__builtin_amdgcn_kernarg_segment_ptr(); asm volatile("" : "+s"(P));
        phase_ymat_toeplitz(P, wid);
        phase_modulate0(P, wid);
    }
    xcd_barrier(wid, lds);

    for (int layer = 0; layer < DEPTH; ++layer) {
        const int j = layer >> 1, mix = layer & 1, nmix = mix ? 5 : 4;
        for (int st = 0; st < nmix + 4; ++st) {
            PP P = (PP)__builtin_amdgcn_kernarg_segment_ptr(); asm volatile("" : "+s"(P));
            unsigned char* ws = P->ws;
            int kind = 0; GemmD g; EpiG e; int rsub = 0;
            const bf16_t* rusrc = (const bf16_t*)(ws + WS_A); const bf16_t* rsrc = (const bf16_t*)(ws + WS_BIG); bf16_t* rdst = (bf16_t*)(ws + WS_A);
            g.tilesPerBatch = 1 << 30; g.bBatchStride = 0; g.lda = D; g.ldb = D; g.K = D; g.nM = MT / BM; g.nN = 4; g.A = (const bf16_t*)(ws + WS_A); g.Bt = nullptr;
            e.kind = 0; e.O = ws + WS_BIG; e.ldc = D; e.layer = layer; e.first = 0; e.wid = wid; e.lds = lds;
            if (st < nmix) {
                if (!mix) {
                    if (st == 0) { g.Bt = (const bf16_t*)(ws + WS_WIN + j * SZ_WIN); g.nN = 3072 / BM; e.kind = 6; }
                    else if (st == 1) kind = 1;
                    else if (st == 2) { g.A = (const bf16_t*)P->out; g.Bt = (const bf16_t*)(ws + WS_WOUT + j * SZ_WOUT); }
                    else { kind = 2; rsub = 0; }
                } else {
                    if (st == 0) { g.A = (const bf16_t*)(ws + WS_BIG); g.Bt = (const bf16_t*)(ws + WS_EMAT + j * SZ_EMAT); g.lda = XLD; g.ldb = 512; g.K = 512; g.nM = NG * XR / BM; g.nN = 1; g.tilesPerBatch = XR / BM; g.bBatchStride = (size_t)256 * 512;
                        e.kind = 0; e.ldc = 256; e.O = ws + WS_A; }
                    else if (st == 1) kind = 3;
                    else if (st == 2) { g.A = (const bf16_t*)(ws + WS_BIG); g.Bt = (const bf16_t*)(ws + WS_YMAT + j * SZ_YMAT); g.lda = XLD; g.ldb = XLD; g.K = XLD; g.nM = NG * XR / BM; g.nN = 2; g.tilesPerBatch = XR / BM; g.bBatchStride = (size_t)512 * XLD;
                        e.kind = 2; e.O = ws + WS_A; }
                    else if (st == 3) { g.Bt = (const bf16_t*)(ws + WS_WGLU + j * SZ_WGLU); g.nN = 2048 / BM; e.kind = 5; e.O = P->out; }
                    else { kind = 2; rsub = 0; rusrc = (const bf16_t*)(ws + WS_BIG); rsrc = (const bf16_t*)P->out; }
                }
            } else {
                const int f = st - nmix;
                unsigned char* mbuf = layer == DEPTH - 1 ? ws + WS_DEAD : (unsigned char*)P->out;
                if (f == 0) { g.Bt = (const bf16_t*)(ws + WS_WUP + layer * SZ_WUP); g.nN = F2 / BM; e.kind = 3; }
                else if (f == 1) kind = 4;
                else if (f == 2) { g.A = (const bf16_t*)(ws + WS_BIG); g.Bt = (const bf16_t*)(ws + WS_WDN + layer * SZ_WDN); g.lda = F; g.ldb = F; g.K = F; e.O = mbuf; }
                else { kind = 2; rsub = 1; rsrc = (const bf16_t*)mbuf; if (layer + 1 < DEPTH && ((layer + 1) & 1)) rdst = (bf16_t*)(ws + WS_BIG); }
            }
            int reps = 1;
            if (PROBE == 1 && kind == 0) reps = 2;
            if (PROBE == 4 && kind == 0 && e.kind == 0) reps = 2;
            if (PROBE == 5 && kind == 0 && e.kind == 3) reps = 2;
            if (PROBE == 2 && kind != 0 && kind != 2) reps = 2;
            for (int rep = 0; rep < reps; ++rep) {
            if (kind == 0) gemm_phase(lds, g, e);
            else if (kind == 1) phase_convgate(P, wid, j);
            else if (kind == 2) phase_resid_ln(P, wid, layer, rsub, rusrc, rsrc, rdst);
            else if (kind == 3) phase_scan_local(P, wid, j);
            else phase_ffn_fix(P, wid, layer);
            if (!(mix && st == 0)) xcd_barrier(wid, lds);
            }
            if (PROBE == 3) { xcd_barrier(wid, lds); xcd_barrier(wid, lds); }
        }
    }
}

extern "C" void kernel_launch(void* const* d_in, const int* in_sizes, int n_in, void* d_out, int out_size, void* d_ws, size_t ws_size, hipStream_t stream) {
    static int grid_blocks = 0;
    if (grid_blocks == 0) {
        if (n_in != 27 || ws_size < WS_TOTAL) { fprintf(stderr, "kernel_launch: need 27 inputs and %zu bytes of workspace (got %d, %zu)\n", (size_t)WS_TOTAL, n_in, ws_size); grid_blocks = -1; return; }
        int dev = 0, cus = 0, per_cu = 0;
        hipGetDevice(&dev);
        hipDeviceGetAttribute(&cus, hipDeviceAttributeMultiprocessorCount, dev);
        if (hipFuncSetAttribute((const void*)fwd_megakernel, hipFuncAttributeMaxDynamicSharedMemorySize, LDS_BYTES) != hipSuccess) { fprintf(stderr, "hipFuncSetAttribute failed\n"); grid_blocks = -1; return; }
        hipOccupancyMaxActiveBlocksPerMultiprocessor(&per_cu, (const void*)fwd_megakernel, NTHREADS, LDS_BYTES);
        if (per_cu < 1) { fprintf(stderr, "occupancy query says %d blocks per CU\n", per_cu); per_cu = 1; }
        grid_blocks = cus * 1;
        (void)hipGetLastError();
    }
    if (grid_blocks < 0) return;
    if (hipMemsetAsync((char*)d_ws + WS_BAR, 0, 16384, stream) != hipSuccess) { fprintf(stderr, "memset of barrier words failed\n"); return; }
    Params p{};
    for (int i = 0; i < 27; ++i) p.in[i] = (const float*)d_in[i];
    p.out = (float*)d_out; p.ws = (unsigned char*)d_ws;
    void* args[] = {&p};
    hipError_t e = hipLaunchCooperativeKernel((const void*)fwd_megakernel, dim3(grid_blocks), dim3(NTHREADS), args, LDS_BYTES, stream);
    if (e != hipSuccess) fprintf(stderr, "cooperative launch failed: %s (grid %d)\n", hipGetErrorString(e), grid_blocks);
}
```

```cpp
#include <hip/hip_runtime.h>
#include <hip/hip_cooperative_groups.h>
#include <cstdio>
namespace cg = cooperative_groups;

#define LAS __attribute__((address_space(3)))
typedef unsigned short bf16_t;
typedef short bf16x8 __attribute__((ext_vector_type(8)));
typedef float f32x4 __attribute__((ext_vector_type(4)));
typedef unsigned u32x4 __attribute__((ext_vector_type(4)));
typedef unsigned u32x2 __attribute__((ext_vector_type(2)));
typedef float f32x2 __attribute__((ext_vector_type(2)));

constexpr int D = 1024, F = 2816, F2 = 5632, MT = 81920, NSEQ = 40, SEQL = 2048, NPROMPT_ROWS = 65536;
constexpr int DEPTH = 4;
constexpr int TCH = 32, NCHUNK = 64, XR = NSEQ * NCHUNK  , XLD = 768, NG = 64;
constexpr float ALPHA = 1.681792830507429f;
constexpr float LN_EPS = 1e-5f;
constexpr int NTHREADS = 512;
constexpr int LDS_STAGE = 131072, LDS_CW = LDS_STAGE + 16, LDS_BYTES = LDS_CW + 8 * 1024;

constexpr size_t SZ_WIN = (size_t)3072 * 1024 * 2, SZ_WOUT = (size_t)1024 * 1024 * 2, SZ_WGLU = (size_t)2048 * 1024 * 2;
constexpr size_t SZ_WUP = (size_t)F2 * 1024 * 2, SZ_WDN = (size_t)1024 * F * 2;
constexpr size_t SZ_EMAT = (size_t)NG * 256 * 512 * 2, SZ_YMAT = (size_t)NG * 512 * XLD * 2, SZ_KTAB = (size_t)NG * 2 * 32 * 256 * 4;
constexpr size_t WS_WIN = 0;
constexpr size_t WS_WOUT = WS_WIN + 2 * SZ_WIN;
constexpr size_t WS_WGLU = WS_WOUT + 2 * SZ_WOUT;
constexpr size_t WS_EMAT = WS_WGLU + 2 * SZ_WGLU;
constexpr size_t WS_YMAT = WS_EMAT + 2 * SZ_EMAT;
constexpr size_t WS_KTAB = WS_YMAT + 2 * SZ_YMAT;
constexpr size_t WS_WUP = WS_KTAB + 2 * SZ_KTAB;
constexpr size_t WS_WDN = WS_WUP + 4 * SZ_WUP;
constexpr size_t WS_MOD = WS_WDN + 4 * SZ_WDN;
constexpr size_t WS_DEAD = 0;
static_assert(WS_WUP - WS_DEAD >= (size_t)MT * D * 2, "the dead-weights region must hold one bf16 [MT][D] tensor");
constexpr size_t WS_STAT = WS_MOD + (size_t)DEPTH * NSEQ * 6 * D * 4;
constexpr size_t WS_A = WS_STAT + (size_t)MT * 2 * 4;
constexpr size_t WS_EB = WS_A + (size_t)MT * D * 2;
constexpr size_t WS_BIG = WS_A + (size_t)NG * XR * XLD * 2;
constexpr size_t BIG_Z = (size_t)NG * XR * 256 * 4;
constexpr size_t WS_END = WS_BIG + (size_t)MT * 3072 * 2;
constexpr size_t WS_BAR = (WS_END + 255) / 256 * 256, WS_TOTAL = WS_BAR + 16384;
constexpr int NQ = MT / 64;
static_assert((size_t)NQ * 2 * 2 * F2 * 2 <= (size_t)NG * XR * XLD * 2 - (size_t)MT * D * 2, "edge buffer must fit in the A spare");
static_assert((size_t)MT * F * 2 <= (size_t)MT * 3072 * 2, "gbuf fits BIG");

struct Params {
    const float* in[27];
    float* out;
    unsigned char* ws;
};
typedef const __attribute__((address_space(4))) Params* PP;

__device__ __forceinline__ int fresh_lane() { int l; asm volatile("v_mbcnt_lo_u32_b32 %0, -1, 0\n\tv_mbcnt_hi_u32_b32 %0, -1, %0" : "=v"(l)); return l; }
__device__ __forceinline__ int fresh_tid(int wid) { return wid * 64 + fresh_lane(); }
__device__ __forceinline__ float wave_sum_dpp(float v) {
    v += __builtin_bit_cast(float, __builtin_amdgcn_update_dpp(0, __builtin_bit_cast(int, v), 0x111, 0xf, 0xf, true));
    v += __builtin_bit_cast(float, __builtin_amdgcn_update_dpp(0, __builtin_bit_cast(int, v), 0x112, 0xf, 0xf, true));
    v += __builtin_bit_cast(float, __builtin_amdgcn_update_dpp(0, __builtin_bit_cast(int, v), 0x114, 0xf, 0xf, true));
    v += __builtin_bit_cast(float, __builtin_amdgcn_update_dpp(0, __builtin_bit_cast(int, v), 0x118, 0xf, 0xf, true));
    v += __builtin_bit_cast(float, __builtin_amdgcn_update_dpp(0, __builtin_bit_cast(int, v), 0x142, 0xa, 0xf, false));
    v += __builtin_bit_cast(float, __builtin_amdgcn_update_dpp(0, __builtin_bit_cast(int, v), 0x143, 0xc, 0xf, false));
    return __builtin_bit_cast(float, __builtin_amdgcn_readlane(__builtin_bit_cast(int, v), 63));
}
__device__ __forceinline__ float xor_shfl(float x, int lane, int o) { return __builtin_bit_cast(float, __builtin_amdgcn_ds_bpermute((lane ^ o) << 2, __builtin_bit_cast(int, x))); }
__device__ __forceinline__ unsigned cvt_pk_bf16(float lo, float hi) { unsigned r; asm volatile("v_cvt_pk_bf16_f32 %0, %1, %2" : "=v"(r) : "v"(lo), "v"(hi)); return r; }
__device__ __forceinline__ void unpack8(const u32x4 v, float (&f)[8]) {
#pragma unroll
    for (int i = 0; i < 4; ++i) { f[2 * i] = __uint_as_float(v[i] << 16); f[2 * i + 1] = __uint_as_float(v[i] & 0xffff0000u); }
}
__device__ __forceinline__ u32x4 pack8(const float (&f)[8]) {
    u32x4 r;
#pragma unroll
    for (int i = 0; i < 4; ++i) r[i] = cvt_pk_bf16(f[2 * i], f[2 * i + 1]);
    return r;
}
__device__ __forceinline__ float gelu_tanh(float x) { const float z = x * ((x * x) * (-0.10294324f) + (-2.3022082f)); return x * __builtin_amdgcn_rcpf(1.f + __builtin_amdgcn_exp2f(z)); }
__device__ __forceinline__ float sigmoid_f(float x) { return 1.f / (1.f + __expf(-x)); }
__device__ __forceinline__ float dpp_prev(float x) { return __builtin_bit_cast(float, __builtin_amdgcn_mov_dpp(__builtin_bit_cast(int, x), 0x121, 0xf, 0xf, true)); }
__device__ __forceinline__ float dpp_next(float x) { return __builtin_bit_cast(float, __builtin_amdgcn_mov_dpp(__builtin_bit_cast(int, x), 0x12F, 0xf, 0xf, true)); }
__device__ __forceinline__ void conv4(const float (&x)[4], float w0, float w1, float w2, float b, int fr, float (&c)[4]) {
    float R[4], L[4];
#pragma unroll
    for (int m = 0; m < 4; ++m) { R[m] = dpp_prev(x[m]); L[m] = dpp_next(x[m]); }
#pragma unroll
    for (int m = 0; m < 4; ++m) {
        const float pv = fr > 0 ? R[m] : (m > 0 ? R[m > 0 ? m - 1 : 0] : 0.f);
        const float nx = fr < 15 ? L[m] : (m < 3 ? L[m < 3 ? m + 1 : 3] : 0.f);
        c[m] = b + w1 * x[m] + w0 * pv + w2 * nx;
    }
}
__device__ __forceinline__ void load8f(const float* p, float (&f)[8]) {
    const f32x4 a = *(const f32x4*)p, b = *(const f32x4*)(p + 4);
    f[0] = a[0]; f[1] = a[1]; f[2] = a[2]; f[3] = a[3]; f[4] = b[0]; f[5] = b[1]; f[6] = b[2]; f[7] = b[3];
}
__device__ __forceinline__ void store8f(float* p, const float (&f)[8]) {
    *(f32x4*)p = (f32x4){f[0], f[1], f[2], f[3]}; *(f32x4*)(p + 4) = (f32x4){f[4], f[5], f[6], f[7]};
}
__device__ __forceinline__ const float* xin_row(PP P, int row) {
    return row < NPROMPT_ROWS ? P->in[0] + (size_t)row * D : P->in[1] + (size_t)(row - NPROMPT_ROWS) * D;
}

constexpr int BM = 256, BK = 64, HALF = 128, HTB = HALF * BK * 2, NXCD = 8, WGM = 8;
__device__ __forceinline__ int lds_byte(int r, int c) { const int st = (r >> 4) * 2 + (c >> 5), rr = r & 15, cc = c & 31, ob = rr * 64 + cc * 2; return st * 1024 + (ob ^ (((ob >> 9) & 1) << 5)); }
__device__ __forceinline__ void stage_rc(int b, int& R, int& C) { const int st = b / 1024, sb = b % 1024, swz = sb ^ (((sb >> 9) & 1) << 5); R = (st >> 1) * 16 + swz / 64; C = (st & 1) * 32 + (swz % 64) / 2; }
__device__ __forceinline__ int perm32(int rho) { const int n = rho >> 4, i = rho & 15; return 8 * (i >> 2) + 4 * n + (i & 3); }

struct Unit { int pm, pn; };
struct GemmD {
    const bf16_t* A; const bf16_t* Bt;
    int lda, ldb, K, nM, nN, tilesPerBatch;
    size_t bBatchStride;
};
struct StaticOrder {
    int nM, nN, nwg, G, c;
    __device__ void init(int nM_, int nN_, int G_, int c_) { nM = nM_; nN = nN_; nwg = nM * nN; G = G_; c = c_; }
    __device__ bool next(int i, Unit& u) const {
        const long L = (long)i * G + c; if (L >= nwg) return false;
        int wgid = (int)L; { const int q = nwg / NXCD, r = nwg % NXCD, xcd = wgid % NXCD, off = wgid / NXCD; wgid = (xcd < r ? xcd * (q + 1) : r * (q + 1) + (xcd - r) * q) + off; }
        const int nig = WGM * nN, gid = wgid / nig, fm = gid * WGM, gsz = (nM - fm) < WGM ? (nM - fm) : WGM;
        u.pm = fm + ((wgid % nig) % gsz); u.pn = (wgid % nig) / gsz; return true;
    }
};

struct EpiG {
    int kind; void* O; int ldc; int layer; int first; int wid; LAS unsigned char* lds;
    __device__ __forceinline__ bool perm() const { return kind != 1; }
    __device__ __forceinline__ void operator()(const f32x4 (&acc)[2][2][4][2], const Unit& u) const {
        PP P = (PP)__builtin_amdgcn_kernarg_segment_ptr(); asm volatile("" : "+s"(P));
        const int wr = wid >> 2, wc = wid & 3;
#define EPI_LANE() const int lane2 = fresh_lane(), fr = lane2 & 15, fq = lane2 >> 4
        if (kind == 0) {
            EPI_LANE();
            const int row0 = u.pm * BM + wr * 64 + fr, col0 = u.pn * BM + wc * 32 + 8 * fq;
#pragma unroll
            for (int ai = 0; ai < 2; ++ai)
#pragma unroll
                for (int m = 0; m < 4; ++m) {
                    bf16_t* rowp = (bf16_t*)O + (size_t)(row0 + ai * HALF + m * 16) * ldc + col0;
#pragma unroll
                    for (int bj = 0; bj < 2; ++bj) {
                        const f32x4 v0 = acc[ai][bj][m][0], v1 = acc[ai][bj][m][1];
                        u32x4 o; o[0] = cvt_pk_bf16(v0[0], v0[1]); o[1] = cvt_pk_bf16(v0[2], v0[3]); o[2] = cvt_pk_bf16(v1[0], v1[1]); o[3] = cvt_pk_bf16(v1[2], v1[3]);
                        *(u32x4*)(rowp + bj * HALF) = o;
                    }
                }
        } else if (kind == 1) {
            EPI_LANE();
            const int row0 = u.pm * BM + wr * 64 + fr, col0 = u.pn * BM + wc * 32 + 4 * fq;
#pragma unroll
            for (int ai = 0; ai < 2; ++ai)
#pragma unroll
                for (int m = 0; m < 4; ++m) {
                    float* rowp = (float*)O + (size_t)(row0 + ai * HALF + m * 16) * ldc + col0;
#pragma unroll
                    for (int bj = 0; bj < 2; ++bj)
#pragma unroll
                        for (int n = 0; n < 2; ++n) *(f32x4*)(rowp + bj * HALF + n * 16) = acc[ai][bj][m][n];
                }
        } else if (kind == 3) {
            EPI_LANE();
            const float* cw = P->in[24] + (size_t)layer * 3 * F2; const float* cb = P->in[25] + (size_t)layer * F2;
            bf16_t* eb = (bf16_t*)(P->ws + WS_EB);
            const int ch0 = u.pn * 128 + wc * 32 + 8 * fq;
            const float m0 = fr == 0 ? 1.f : 0.f, n0 = 1.f - m0, m15 = fr == 15 ? 1.f : 0.f, n15 = 1.f - m15;
            LAS unsigned char* wl = lds + LDS_CW + wid * 1024;
            { const int a_ = lane2 >> 3, q4 = (lane2 & 7) * 4;
              const float* src = (a_ < 6 ? cw + (a_ >> 1) * F2 : cb) + (a_ & 1) * F + (unsigned)(u.pn * 128 + wc * 32 + q4);
              const f32x4 wv = *(const f32x4*)src;
              *(LAS f32x4*)(wl + lane2 * 16) = wv; }
            asm volatile("s_waitcnt lgkmcnt(0)" ::: "memory");
#pragma unroll
            for (int ai = 0; ai < 2; ++ai) {
                const int rowb = u.pm * BM + ai * HALF + wr * 64, q = rowb >> 6;
                unsigned gq[4][4], pe[2][2][4];
#pragma unroll
                for (int n = 0; n < 2; ++n) {
                    f32x4 W[2][4];
#pragma unroll
                    for (int part = 0; part < 2; ++part)
#pragma unroll
                        for (int k = 0; k < 4; ++k) W[part][k] = *(const LAS f32x4*)(wl + (k * 2 + part) * 128 + (8 * fq + 4 * n) * 4);
#pragma unroll
                    for (int ep = 0; ep < 2; ++ep) {
                        f32x2 cres[2][4];
#pragma unroll
                        for (int part = 0; part < 2; ++part) {
                            const f32x2 w0 = (f32x2){W[part][0][2 * ep], W[part][0][2 * ep + 1]}, w1 = (f32x2){W[part][1][2 * ep], W[part][1][2 * ep + 1]};
                            const f32x2 w2 = (f32x2){W[part][2][2 * ep], W[part][2][2 * ep + 1]}, bb = (f32x2){W[part][3][2 * ep], W[part][3][2 * ep + 1]};
                            const f32x2 w0a = w0 * n0, w0b = w0 * m0, w2a = w2 * n15, w2b = w2 * m15;
                            f32x2 X[4], R[4], L[4];
#pragma unroll
                            for (int m = 0; m < 4; ++m) { X[m] = (f32x2){acc[ai][part][m][n][2 * ep], acc[ai][part][m][n][2 * ep + 1]};
                                R[m] = (f32x2){dpp_prev(X[m].x), dpp_prev(X[m].y)}; L[m] = (f32x2){dpp_next(X[m].x), dpp_next(X[m].y)}; }
#pragma unroll
                            for (int m = 0; m < 4; ++m) {
                                f32x2 c = X[m] * w1 + bb; c = R[m] * w0a + c; c = L[m] * w2a + c;
                                if (m > 0) c = R[m > 0 ? m - 1 : 0] * w0b + c;
                                if (m < 3) c = L[m < 3 ? m + 1 : 3] * w2b + c;
                                cres[part][m] = c;
                            }
                            pe[0][part][n * 2 + ep] = cvt_pk_bf16(cres[part][0].x, cres[part][0].y);
                            pe[1][part][n * 2 + ep] = cvt_pk_bf16(cres[part][3].x, cres[part][3].y);
                            __builtin_amdgcn_sched_barrier(0);
                        }
#pragma unroll
                        for (int m = 0; m < 4; ++m) {
                            const f32x2 a = cres[0][m], v = cres[1][m];
                            const f32x2 t = (a * a) * (-0.10294324f) + (-2.3022082f), z = a * t;
                            f32x2 d; d.x = __builtin_amdgcn_exp2f(z.x) + 1.f; d.y = __builtin_amdgcn_exp2f(z.y) + 1.f;
                            f32x2 r; r.x = __builtin_amdgcn_rcpf(d.x); r.y = __builtin_amdgcn_rcpf(d.y);
                            const f32x2 o = (a * v) * r;
                            gq[m][n * 2 + ep] = cvt_pk_bf16(o.x, o.y);
                        }
                        __builtin_amdgcn_sched_barrier(0);
                    }
                }
                if (fr == 0 || fr == 15) {
                    const bool sel = fr == 15;
                    bf16_t* ep_ = eb + (unsigned)((((q * 2 + (sel ? 1 : 0)) * 352 + (ch0 >> 3)) * 4) * 8);
#pragma unroll
                    for (int part = 0; part < 2; ++part) {
                        float rw[8];
#pragma unroll
                        for (int e = 0; e < 8; ++e) rw[e] = sel ? acc[ai][part][3][e >> 2][e & 3] : acc[ai][part][0][e >> 2][e & 3];
                        *(u32x4*)(ep_ + part * 8) = pack8(rw);
                        *(u32x4*)(ep_ + (2 + part) * 8) = (u32x4){sel ? pe[1][part][0] : pe[0][part][0], sel ? pe[1][part][1] : pe[0][part][1], sel ? pe[1][part][2] : pe[0][part][2], sel ? pe[1][part][3] : pe[0][part][3]};
                    }
                }
#pragma unroll
                for (int m = 0; m < 4; ++m) {
                    const bool edge = (m == 0 && fr == 0) || (m == 3 && fr == 15);
                    if (!edge) *(u32x4*)((bf16_t*)O + (unsigned)((rowb + m * 16 + fr) * F + ch0)) = (u32x4){gq[m][0], gq[m][1], gq[m][2], gq[m][3]};
                }
            }
        } else if (kind == 6) {
            EPI_LANE();
            if (u.pn < 8) {
                const int c0 = u.pn * 128 + wc * 32 + 8 * fq;
#pragma unroll
                for (int ai = 0; ai < 2; ++ai)
#pragma unroll
                    for (int m = 0; m < 4; ++m) {
                        const int row = u.pm * BM + ai * HALF + wr * 64 + m * 16 + fr;
                        float qv[8];
#pragma unroll
                        for (int e = 0; e < 8; ++e) qv[e] = acc[ai][0][m][e >> 2][e & 3] * acc[ai][1][m][e >> 2][e & 3];
                        *(u32x4*)((bf16_t*)O + (unsigned)(row * 2048 + c0)) = pack8(qv);
                    }
            } else {
                const int c0 = D + (u.pn - 8) * BM + wc * 32 + 8 * fq;
#pragma unroll
                for (int ai = 0; ai < 2; ++ai)
#pragma unroll
                    for (int m = 0; m < 4; ++m) {
                        const int row = u.pm * BM + ai * HALF + wr * 64 + m * 16 + fr;
#pragma unroll
                        for (int bj = 0; bj < 2; ++bj) {
                            float bv[8];
#pragma unroll
                            for (int e = 0; e < 8; ++e) bv[e] = acc[ai][bj][m][e >> 2][e & 3];
                            *(u32x4*)((bf16_t*)O + (unsigned)(row * 2048 + c0 + bj * HALF)) = pack8(bv);
                        }
                    }
            }
        } else if (kind == 5) {
            EPI_LANE();
            const int c0 = u.pn * 128 + wc * 32 + 8 * fq;
#pragma unroll
            for (int ai = 0; ai < 2; ++ai)
#pragma unroll
                for (int m = 0; m < 4; ++m) {
                    const int row = u.pm * BM + ai * HALF + wr * 64 + m * 16 + fr;
                    float mv[8];
#pragma unroll
                    for (int e = 0; e < 8; ++e) mv[e] = acc[ai][0][m][e >> 2][e & 3] * __builtin_amdgcn_rcpf(1.f + __builtin_amdgcn_exp2f(-1.4426950409f * acc[ai][1][m][e >> 2][e & 3]));
                    *(u32x4*)((bf16_t*)O + (unsigned)(row * D + c0)) = pack8(mv);
                }
        } else {
            EPI_LANE();
            const int row0 = u.pm * BM + wr * 64 + fr, col0 = u.pn * BM + wc * 32 + 8 * fq;
#pragma unroll
            for (int ai = 0; ai < 2; ++ai)
#pragma unroll
                for (int m = 0; m < 4; ++m) {
                    const int row = row0 + ai * HALF + m * 16, g = row / XR, r = row - g * XR;
#pragma unroll
                    for (int bj = 0; bj < 2; ++bj) {
                        const int col = col0 + bj * HALF, t = col >> 4, i0 = col & 15;
                        const f32x4 v0 = acc[ai][bj][m][0], v1 = acc[ai][bj][m][1];
                        u32x4 o; o[0] = cvt_pk_bf16(gelu_tanh(v0[0]), gelu_tanh(v0[1])); o[1] = cvt_pk_bf16(gelu_tanh(v0[2]), gelu_tanh(v0[3]));
                        o[2] = cvt_pk_bf16(gelu_tanh(v1[0]), gelu_tanh(v1[1])); o[3] = cvt_pk_bf16(gelu_tanh(v1[2]), gelu_tanh(v1[3]));
                        *(u32x4*)((bf16_t*)O + (size_t)(r * TCH + t) * D + g * 16 + i0) = o;
                    }
                }
        }
    }
};

__device__ __forceinline__ void gemm_phase(LAS unsigned char* lds, const GemmD& g, const EpiG& E) {
    const int wid = E.wid, tid = fresh_tid(wid), lane = tid & 63, wr = wid >> 2, wc = wid & 3, fr = lane & 15, fq = lane >> 4;
    const int K = g.K, nt = K / BK;
    StaticOrder S; S.init(g.nM, g.nN, gridDim.x, blockIdx.x);
    unsigned voffA[2], voffB[2];
#pragma unroll
    for (int i = 0; i < 2; ++i) { int R, C; stage_rc(tid * 16 + i * 8192, R, C); const int Rb = E.perm() ? ((R & ~31) + perm32(R & 31)) : R;
        voffA[i] = (unsigned)(R * g.lda + C) * 2u; voffB[i] = (unsigned)(Rb * g.ldb + C) * 2u; }
    const __amdgpu_buffer_rsrc_t rA = __builtin_amdgcn_make_buffer_rsrc((void*)g.A, (short)0, 0x7fffffff, 0x00020000);
    const __amdgpu_buffer_rsrc_t rB = __builtin_amdgcn_make_buffer_rsrc((void*)g.Bt, (short)0, 0x7fffffff, 0x00020000);
    const unsigned kstep = (unsigned)(BK * 2);
    const unsigned hstepA = (unsigned)HALF * g.lda * 2, hstepB = (unsigned)HALF * g.ldb * 2;
    const unsigned tstepA = 2 * hstepA, tstepB = 2 * hstepB;
    const unsigned ldsw = (unsigned)wid * 1024u;
    const int aoff = lds_byte(wr * 64 + fr, fq * 8), boff = lds_byte(wc * 32 + fr, fq * 8);
#define PG8_SA(b, h) (((b) * 2 + (h)) * HTB)
#define PG8_SB(b, h) ((4 + (b) * 2 + (h)) * HTB)
#define PG8_STAGE(bufoff, soff, R, voff) do { _Pragma("unroll") for (int _i = 0; _i < 2; ++_i) \
        __builtin_amdgcn_raw_ptr_buffer_load_lds(R, (LAS unsigned*)(lds + (bufoff) + ldsw + _i * 8192), 16, (int)(voff)[_i], (int)(soff), 0, 0); } while (0)
#define PG8_LDA(dst, b, h) do { _Pragma("unroll") for (int m = 0; m < 4; ++m) _Pragma("unroll") for (int k = 0; k < 2; ++k) dst[m][k] = *(const LAS bf16x8*)(lds + PG8_SA(b, h) + aoff + m * 2048 + k * 1024); } while (0)
#define PG8_LDB(dst, b, h) do { _Pragma("unroll") for (int n = 0; n < 2; ++n) _Pragma("unroll") for (int k = 0; k < 2; ++k) dst[n][k] = *(const LAS bf16x8*)(lds + PG8_SB(b, h) + boff + n * 2048 + k * 1024); } while (0)
#define PG8_MMA(ai, bj, At, Bt) do { __builtin_amdgcn_s_setprio(1); _Pragma("unroll") for (int m = 0; m < 4; ++m) _Pragma("unroll") for (int n = 0; n < 2; ++n) _Pragma("unroll") for (int k = 0; k < 2; ++k) \
        acc[ai][bj][m][n] = __builtin_amdgcn_mfma_f32_16x16x32_bf16(Bt[n][k], At[m][k], acc[ai][bj][m][n], 0, 0, 0); __builtin_amdgcn_s_setprio(0); } while (0)
#define PG8_WAIT_V(n) asm volatile("s_waitcnt vmcnt(" #n ")" ::: "memory")
#define PG8_WAIT_L(n) asm volatile("s_waitcnt lgkmcnt(" #n ")" ::: "memory")
#define PG8_BAR __builtin_amdgcn_s_barrier()
#define PG8_SCHED __builtin_amdgcn_sched_barrier(0)
    Unit cur, nxt; int ui = 0;
    if (!S.next(0, cur)) return;
    f32x4 acc[2][2][4][2];
#pragma unroll
    for (int a = 0; a < 2; ++a)
#pragma unroll
        for (int b = 0; b < 2; ++b)
#pragma unroll
            for (int m = 0; m < 4; ++m)
#pragma unroll
                for (int n = 0; n < 2; ++n) acc[a][b][m][n] = (f32x4){0.f, 0.f, 0.f, 0.f};
    bf16x8 At[4][2], B0[2][2], B1[2][2];
    unsigned cA = (unsigned)cur.pm * tstepA;
    unsigned cB = (unsigned)(((size_t)(cur.pm / g.tilesPerBatch) * g.bBatchStride) * 2) + (unsigned)cur.pn * tstepB;
    PG8_STAGE(PG8_SB(0, 0), cB, rB, voffB); PG8_STAGE(PG8_SA(0, 0), cA, rA, voffA); PG8_STAGE(PG8_SB(0, 1), cB + hstepB, rB, voffB); PG8_STAGE(PG8_SA(0, 1), cA + hstepA, rA, voffA);
    if (wr == 1) PG8_BAR;
    PG8_WAIT_V(4); PG8_BAR;
    PG8_STAGE(PG8_SB(1, 0), cB + kstep, rB, voffB); PG8_STAGE(PG8_SA(1, 0), cA + kstep, rA, voffA); PG8_STAGE(PG8_SB(1, 1), cB + hstepB + kstep, rB, voffB);
    PG8_WAIT_V(6); PG8_BAR;
    for (;;) {
        const bool has_next = S.next(ui + 1, nxt);
        const unsigned nA = has_next ? (unsigned)nxt.pm * tstepA : cA;
        const unsigned nB = has_next ? (unsigned)(((size_t)(nxt.pm / g.tilesPerBatch) * g.bBatchStride) * 2) + (unsigned)nxt.pn * tstepB : cB;
        for (int t = 0; t < nt; t += 2) {
            const bool last = (t == nt - 2);
            const unsigned a1 = cA + (unsigned)(t + 1) * kstep;
            const unsigned a2 = last ? nA : cA + (unsigned)(t + 2) * kstep; const unsigned b2 = last ? nB : cB + (unsigned)(t + 2) * kstep;
            const unsigned a3 = a2 + kstep; const unsigned b3 = b2 + kstep;
            PG8_LDB(B0, 0, 0); PG8_SCHED; PG8_LDA(At, 0, 0); PG8_STAGE(PG8_SA(1, 1), a1 + hstepA, rA, voffA);
            PG8_WAIT_L(8); PG8_BAR; PG8_WAIT_L(0); PG8_MMA(0, 0, At, B0); PG8_BAR; PG8_SCHED;
            PG8_LDB(B1, 0, 1); PG8_STAGE(PG8_SB(0, 0), b2, rB, voffB);
            PG8_BAR; PG8_WAIT_L(0); PG8_MMA(0, 1, At, B1); PG8_BAR;
            PG8_LDA(At, 0, 1); PG8_STAGE(PG8_SA(0, 0), a2, rA, voffA);
            PG8_BAR; PG8_WAIT_L(0); PG8_MMA(1, 0, At, B0); PG8_BAR; PG8_SCHED;
            PG8_STAGE(PG8_SB(0, 1), b2 + hstepB, rB, voffB);
            PG8_WAIT_V(6); PG8_BAR; PG8_MMA(1, 1, At, B1); PG8_BAR;
            PG8_LDB(B0, 1, 0); PG8_SCHED; PG8_LDA(At, 1, 0); PG8_STAGE(PG8_SA(0, 1), a2 + hstepA, rA, voffA);
            PG8_WAIT_L(8); PG8_BAR; PG8_WAIT_L(0); PG8_MMA(0, 0, At, B0); PG8_BAR; PG8_SCHED;
            PG8_LDB(B1, 1, 1); PG8_STAGE(PG8_SB(1, 0), b3, rB, voffB);
            PG8_BAR; PG8_WAIT_L(0); PG8_MMA(0, 1, At, B1); PG8_BAR;
            PG8_LDA(At, 1, 1); PG8_STAGE(PG8_SA(1, 0), a3, rA, voffA);
            PG8_BAR; PG8_WAIT_L(0); PG8_MMA(1, 0, At, B0); PG8_BAR; PG8_SCHED;
            PG8_STAGE(PG8_SB(1, 1), b3 + hstepB, rB, voffB);
            PG8_WAIT_V(6); PG8_BAR; PG8_MMA(1, 1, At, B1); PG8_BAR;
        }
        E(acc, cur);
        if (!has_next) break;
#pragma unroll
        for (int a = 0; a < 2; ++a)
#pragma unroll
            for (int b = 0; b < 2; ++b)
#pragma unroll
                for (int m = 0; m < 4; ++m)
#pragma unroll
                    for (int n = 0; n < 2; ++n) acc[a][b][m][n] = (f32x4){0.f, 0.f, 0.f, 0.f};
        cur = nxt; cA = nA; cB = nB; ++ui;
    }
    PG8_WAIT_V(0);
    if (wr == 0) PG8_BAR;
    PG8_BAR;
#undef PG8_SA
#undef PG8_SB
#undef PG8_STAGE
#undef PG8_LDA
#undef PG8_LDB
#undef PG8_MMA
#undef PG8_WAIT_V
#undef PG8_WAIT_L
#undef PG8_BAR
#undef PG8_SCHED
}

__device__ __forceinline__ void transpose_tile4(int wid, LAS float* tile, const float* src, bf16_t* dst, int K, int N, int k0, int nt4, int pair) {
    const int t = fresh_tid(wid);
    { const int row = t >> 3, c8 = (t & 7) * 8;
#pragma unroll
      for (int q = 0; q < 4; ++q) { const int nt = nt4 * 4 + q, n0src = pair > 0 ? ((nt >> 1) & 1) * pair + (nt >> 2) * 128 + (nt & 1) * 64 : pair < 0 ? (nt < 32 ? D + ((nt >> 1) & 1) * D + (nt >> 2) * 128 + (nt & 1) * 64 : (nt - 32) * 64) : nt * 64;
          float f[8]; load8f(src + (size_t)(k0 + row) * N + n0src + c8, f);
#pragma unroll
          for (int e = 0; e < 8; ++e) tile[q * 4160 + row * 65 + c8 + e] = f[e]; } }
    __syncthreads();
    { const int n = t >> 3, k8 = (t & 7) * 8;
#pragma unroll
      for (int q = 0; q < 4; ++q) { float f[8];
#pragma unroll
          for (int e = 0; e < 8; ++e) f[e] = tile[q * 4160 + (k8 + e) * 65 + n];
          *(u32x4*)(dst + (size_t)(nt4 * 256 + q * 64 + n) * K + k0 + k8) = pack8(f); } }
    __syncthreads();
}

constexpr int NT_WIN = 2 * 16 * 12, NT_WOUT = 2 * 16 * 4, NT_WGLU = 2 * 16 * 8, NT_WUP = 4 * 16 * 22, NT_WDN = 4 * 44 * 4;
constexpr int IT_ADA = DEPTH * (6 * D / 128);
constexpr int IT_S5 = 2 * NG * 2;
constexpr int IT_TR0 = IT_ADA + IT_S5;
constexpr int IT_TOTAL = IT_TR0 + NT_WIN + NT_WOUT + NT_WGLU + NT_WUP + NT_WDN;

__device__ void phase0_item(PP P, int wid, LAS unsigned char* lds, int item) {
    const int tid = fresh_tid(wid);
    if (item < IT_ADA) {
        const int layer = item / 48, nb = item % 48, col = nb * 128 + (tid & 127), bg = tid >> 7;
        LAS float* cs = (LAS float*)lds;
        const float* W = P->in[4] + (size_t)layer * D * 6 * D;
        float acc[10];
#pragma unroll
        for (int i = 0; i < 10; ++i) acc[i] = 0.f;
        for (int kc = 0; kc < 4; ++kc) {
            __syncthreads();
            for (int e = tid; e < 40 * 256; e += NTHREADS) { const int b = e >> 8, k = kc * 256 + (e & 255);
                const float c = b < 32 ? P->in[2][b * D + k] : P->in[3][(b - 32) * D + k]; cs[e] = c / (1.f + __expf(-c)); }
            __syncthreads();
            for (int k = 0; k < 256; k += 4) {
                const float* wp = W + (size_t)(kc * 256 + k) * (6 * D) + col;
                const float w0 = wp[0], w1 = wp[6 * D], w2 = wp[2 * 6 * D], w3 = wp[3 * 6 * D];
#pragma unroll
                for (int i = 0; i < 10; ++i) { const f32x4 c4 = *(const LAS f32x4*)(cs + (bg * 10 + i) * 256 + k); acc[i] += c4[0] * w0 + c4[1] * w1 + c4[2] * w2 + c4[3] * w3; } }
        }
        const float bias = P->in[5][layer * 6 * D + col];
        float* mod = (float*)(P->ws + WS_MOD);
#pragma unroll
        for (int i = 0; i < 10; ++i) mod[((size_t)layer * NSEQ + bg * 10 + i) * (6 * D) + col] = acc[i] + bias;
        __syncthreads();
        return;
    }
    item -= IT_ADA;
    if (item < IT_S5) {
        const int j = item >> 7, g = (item >> 1) & 63, k = item & 1;
        LAS float* pwr = (LAS float*)lds;
        LAS float* pwi = pwr + 33 * 64;
        LAS float* Cre = pwi + 33 * 64;
        LAS float* Cim = Cre + 16 * 64;
        LAS float* Bbr = Cim + 16 * 64;
        LAS float* Bbi = Bbr + 64 * 16;
        const size_t pbase = ((size_t)(j * 2 + k) * NG + g);
        const float dt = expf(P->in[16][pbase]);
        __syncthreads();
        for (int e = tid; e < 33 * 64; e += NTHREADS) { const int tau = e >> 6, p = e & 63;
            const float lr = P->in[14][pbase * 64 + p], li = P->in[15][pbase * 64 + p];
            const float mag = expf(lr * dt * (float)tau), ang = li * dt * (float)tau;
            pwr[e] = mag * cosf(ang); pwi[e] = mag * sinf(ang); }
        for (int e = tid; e < 1024; e += NTHREADS) { Cre[e] = P->in[19][pbase * 1024 + e]; Cim[e] = P->in[20][pbase * 1024 + e]; }
        __syncthreads();
        for (int e = tid; e < 1024; e += NTHREADS) { const int p = e >> 4;
            const float lr = P->in[14][pbase * 64 + p], li = P->in[15][pbase * 64 + p];
            const float lbr = pwr[64 + p], lbi = pwi[64 + p], den = lr * lr + li * li;
            const float fr_ = ((lbr - 1.f) * lr + lbi * li) / den, fi_ = (lbi * lr - (lbr - 1.f) * li) / den;
            const float br = P->in[17][pbase * 1024 + e], bi = P->in[18][pbase * 1024 + e];
            Bbr[e] = fr_ * br - fi_ * bi; Bbi[e] = fr_ * bi + fi_ * br; }
        __syncthreads();
        float* kt = (float*)(P->ws + WS_KTAB) + ((size_t)(j * NG + g) * 2 + k) * 32 * 256;
        { const int tau = tid >> 4, i = tid & 15;
            float sacc[16];
#pragma unroll
            for (int jj = 0; jj < 16; ++jj) sacc[jj] = 0.f;
            for (int p = 0; p < 64; ++p) { const float cr = Cre[i * 64 + p], ci = Cim[i * 64 + p], pr = pwr[tau * 64 + p], pi = pwi[tau * 64 + p];
                const float xr = cr * pr - ci * pi, xi = cr * pi + ci * pr;
#pragma unroll
                for (int j4 = 0; j4 < 4; ++j4) { const f32x4 br = *(const LAS f32x4*)(Bbr + p * 16 + j4 * 4), bi = *(const LAS f32x4*)(Bbi + p * 16 + j4 * 4);
#pragma unroll
                    for (int q = 0; q < 4; ++q) sacc[j4 * 4 + q] += xr * br[q] - xi * bi[q]; } }
#pragma unroll
            for (int j4 = 0; j4 < 4; ++j4) *(f32x4*)(kt + tau * 256 + i * 16 + j4 * 4) = (f32x4){sacc[j4 * 4], sacc[j4 * 4 + 1], sacc[j4 * 4 + 2], sacc[j4 * 4 + 3]}; }
        bf16_t* em = (bf16_t*)(P->ws + WS_EMAT) + ((size_t)(j * NG + g) * 256 + k * 128) * 512;
        for (int e = tid; e < 128 * 64; e += NTHREADS) { const int n = e >> 6, kk8 = (e & 63) * 8, p = n & 63, im = n >> 6, s = kk8 >> 4, j0 = kk8 & 15;
            const int pw_e = k == 0 ? (TCH - 1 - s) : s; const float pr = pwr[pw_e * 64 + p], pi = pwi[pw_e * 64 + p]; float f[8];
#pragma unroll
            for (int q = 0; q < 8; ++q) { const float br = Bbr[p * 16 + j0 + q], bi = Bbi[p * 16 + j0 + q]; f[q] = im ? (pr * bi + pi * br) : (pr * br - pi * bi); }
            *(u32x4*)(em + (size_t)n * 512 + kk8) = pack8(f); }
        bf16_t* ym = (bf16_t*)(P->ws + WS_YMAT) + (size_t)(j * NG + g) * 512 * XLD + 512 + k * 128;
        for (int e = tid; e < 512 * 16; e += NTHREADS) { const int n = e >> 4, c8 = (e & 15) * 8, t = n >> 4, i = n & 15, im = c8 >> 6, p0 = c8 & 63;
            const int pw_e = k == 0 ? (t + 1) : (TCH - t); float f[8];
#pragma unroll
            for (int q = 0; q < 8; ++q) { const int p = p0 + q; const float cr = Cre[i * 64 + p], ci = Cim[i * 64 + p], pr = pwr[pw_e * 64 + p], pi = pwi[pw_e * 64 + p];
                f[q] = im ? -(cr * pi + ci * pr) : (cr * pr - ci * pi); }
            *(u32x4*)(ym + (size_t)n * XLD + c8) = pack8(f); }
        __syncthreads();
        return;
    }
    item -= IT_S5;
    LAS float* tile = (LAS float*)lds;
    if (item < NT_WIN) { const int l = item / 192, r = item % 192, kt = r / 12, nt4 = r % 12;
        transpose_tile4(wid, tile, P->in[10] + (size_t)l * D * 3072, (bf16_t*)(P->ws + WS_WIN + l * SZ_WIN), D, 3072, kt * 64, nt4, -1); return; }
    item -= NT_WIN;
    if (item < NT_WOUT) { const int l = item / 64, r = item % 64, kt = r / 4, nt4 = r % 4;
        transpose_tile4(wid, tile, P->in[13] + (size_t)l * D * D, (bf16_t*)(P->ws + WS_WOUT + l * SZ_WOUT), D, D, kt * 64, nt4, 0); return; }
    item -= NT_WOUT;
    if (item < NT_WGLU) { const int l = item / 128, r = item % 128, kt = r / 8, nt4 = r % 8;
        transpose_tile4(wid, tile, P->in[22] + (size_t)l * D * 2048, (bf16_t*)(P->ws + WS_WGLU + l * SZ_WGLU), D, 2048, kt * 64, nt4, D); return; }
    item -= NT_WGLU;
    if (item < NT_WUP) { const int l = item / 352, r = item % 352, kt = r / 22, nt4 = r % 22;
        transpose_tile4(wid, tile, P->in[23] + (size_t)l * D * F2, (bf16_t*)(P->ws + WS_WUP + l * SZ_WUP), D, F2, kt * 64, nt4, F); return; }
    item -= NT_WUP;
    { const int l = item / 176, r = item % 176, kt = r / 4, nt4 = r % 4;
        transpose_tile4(wid, tile, P->in[26] + (size_t)l * F * D, (bf16_t*)(P->ws + WS_WDN + l * SZ_WDN), F, D, kt * 64, nt4, 0); }
}

__device__ void phase_ymat_toeplitz(PP P, int wid) {
    const int tidx = fresh_tid(wid);
    const size_t total = (size_t)2 * NG * 512 * 64;
    const float* ktab = (const float*)(P->ws + WS_KTAB);
    for (size_t it = (size_t)blockIdx.x * NTHREADS + tidx; it < total; it += (size_t)gridDim.x * NTHREADS) {
        const int k8 = (int)(it & 63) * 8, n = (int)(it >> 6) & 511, jg = (int)(it >> 15);
        const int t = n >> 4, i = n & 15, s = k8 >> 4, j0 = k8 & 15;
        const float* kf = ktab + ((size_t)jg * 2 + 0) * 32 * 256, *kb = ktab + ((size_t)jg * 2 + 1) * 32 * 256;
        float f[8];
        if (s < t) { load8f(kf + (t - s) * 256 + i * 16 + j0, f); }
        else if (s > t) { load8f(kb + (s - t) * 256 + i * 16 + j0, f); }
        else { float a[8], b[8]; load8f(kf + i * 16 + j0, a); load8f(kb + i * 16 + j0, b);
            const int j = jg >> 6, g = jg & 63; const float dsk = P->in[21][j * D + g * 16 + i];
#pragma unroll
            for (int q = 0; q < 8; ++q) f[q] = a[q] + b[q] + ((j0 + q) == i ? dsk : 0.f); }
        *(u32x4*)((bf16_t*)(P->ws + WS_YMAT) + ((size_t)jg * 512 + n) * XLD + k8) = pack8(f);
    }
}

__device__ __forceinline__ void store_A(bf16_t* A, bool xlayout, int token, int c8, const float (&u)[8]) {
    if (!xlayout) *(u32x4*)(A + (size_t)token * D + c8) = pack8(u);
    else { const int g = c8 >> 4, i0 = c8 & 15, r = token >> 5, t = token & 31; *(u32x4*)(A + ((size_t)g * XR + r) * XLD + t * 16 + i0) = pack8(u); }
}

__device__ __forceinline__ void load_A(const bf16_t* A, bool xlayout, int token, int c8, float (&u)[8]) {
    if (!xlayout) unpack8(*(const u32x4*)(A + (size_t)token * D + c8), u);
    else { const int g = c8 >> 4, i0 = c8 & 15, r = token >> 5, t = token & 31; unpack8(*(const u32x4*)(A + ((size_t)g * XR + r) * XLD + t * 16 + i0), u); }
}

__device__ void phase_modulate0(PP P, int wid) {
    const int tidx = fresh_tid(wid);
    const float* mod = (const float*)(P->ws + WS_MOD);
    bf16_t* A = (bf16_t*)(P->ws + WS_A);
    for (size_t it = (size_t)blockIdx.x * NTHREADS + tidx; it < (size_t)MT * 128; it += (size_t)gridDim.x * NTHREADS) {
        const int token = (int)(it >> 7), c8 = (int)(it & 127) * 8, seq = token >> 11;
        float x[8], sh[8], sc[8], u[8];
        load8f(xin_row(P, token) + c8, x);
        const float* mrow = mod + (size_t)(0 * NSEQ + seq) * 6 * D;
        load8f(mrow + c8, sh); load8f(mrow + D + c8, sc);
#pragma unroll
        for (int e = 0; e < 8; ++e) u[e] = x[e] * (1.f + sc[e]) + sh[e];
        store_A(A, false, token, c8, u);
    }
}

__device__ void phase_resid_ln(PP P, int wid, int layer, int sub, const bf16_t* usrc, const bf16_t* msrc, bf16_t* Adst) {
    const int tidx = fresh_tid(wid);
    const float* mod = (const float*)(P->ws + WS_MOD);
    const int wv = tidx >> 6, lane = tidx & 63;
    const float* lng = P->in[sub == 0 ? 6 : 8] + layer * D, *lnb = P->in[sub == 0 ? 7 : 9] + layer * D;
    const int nl = sub == 0 ? layer : layer + 1, nsub = sub == 0 ? 1 : 0;
    const bool has_next = nl < DEPTH, xlayout = has_next && nsub == 0 && (nl & 1), x_from_input = layer == 0 && sub == 0;
    const bool src_xlayout = sub == 0 && (layer & 1);
    const int rpw = (MT + (int)gridDim.x - 1) / (int)gridDim.x, rbeg = blockIdx.x * rpw, rend = (rbeg + rpw) < MT ? (rbeg + rpw) : MT;
    float gm[16], bt[16], gt[16], sh[16], sc[16], nsh[16], nsc[16];
#pragma unroll
    for (int h = 0; h < 2; ++h) { float t[8]; load8f(lng + h * 512 + lane * 8, t);
#pragma unroll
        for (int e = 0; e < 8; ++e) gm[h * 8 + e] = t[e];
        load8f(lnb + h * 512 + lane * 8, t);
#pragma unroll
        for (int e = 0; e < 8; ++e) bt[h * 8 + e] = t[e]; }
    int cur_seq = -1;
    for (int row = rbeg + wv; row < rend; row += 16) {
        const int seq = row >> 11;
        if (seq != cur_seq) {
            cur_seq = seq;
            const float* mrow = mod + (size_t)(layer * NSEQ + seq) * 6 * D;
            const float* nmrow = mod + (size_t)((has_next ? nl : 0) * NSEQ + seq) * 6 * D;
#pragma unroll
            for (int h = 0; h < 2; ++h) { const int c8 = h * 512 + lane * 8; float t[8];
                load8f(mrow + (sub == 0 ? 2 : 5) * D + c8, t);
#pragma unroll
                for (int e = 0; e < 8; ++e) gt[h * 8 + e] = 1.f + t[e];
                load8f(mrow + (sub == 0 ? 0 : 3) * D + c8, t);
#pragma unroll
                for (int e = 0; e < 8; ++e) sh[h * 8 + e] = t[e];
                load8f(mrow + (sub == 0 ? 1 : 4) * D + c8, t);
#pragma unroll
                for (int e = 0; e < 8; ++e) sc[h * 8 + e] = __builtin_amdgcn_rcpf(1.f + t[e]);
                load8f(nmrow + (nsub == 0 ? 0 : 3) * D + c8, t);
#pragma unroll
                for (int e = 0; e < 8; ++e) nsh[h * 8 + e] = t[e];
                load8f(nmrow + (nsub == 0 ? 1 : 4) * D + c8, t);
#pragma unroll
                for (int e = 0; e < 8; ++e) nsc[h * 8 + e] = 1.f + t[e]; }
        }
        const int row2 = row + 8;
        const int nr = (row2 < rend && (row2 >> 11) == seq) ? 2 : 1;
        float y[2][16], sum[2] = {0.f, 0.f}, sq[2] = {0.f, 0.f};
#pragma unroll
        for (int rr = 0; rr < 2; ++rr) {
            if (rr < nr) {
                const int r = row + rr * 8;
#pragma unroll
                for (int h = 0; h < 2; ++h) {
                    const int c8 = h * 512 + lane * 8; float x[8], m[8];
                    if (x_from_input) load8f(xin_row(P, r) + c8, x);
                    else { float u[8]; load_A(usrc, src_xlayout, r, c8, u);
#pragma unroll
                        for (int e = 0; e < 8; ++e) x[e] = (u[e] - sh[h * 8 + e]) * sc[h * 8 + e]; }
                    unpack8(*(const u32x4*)(msrc + (size_t)r * D + c8), m);
#pragma unroll
                    for (int e = 0; e < 8; ++e) { const float v = ALPHA * x[e] + gt[h * 8 + e] * m[e]; y[rr][h * 8 + e] = v; sum[rr] += v; sq[rr] += v * v; }
                }
            }
        }
#pragma unroll
        for (int rr = 0; rr < 2; ++rr) {
            if (rr < nr) {
                const int r = row + rr * 8;
                const float ts = wave_sum_dpp(sum[rr]), tq = wave_sum_dpp(sq[rr]);
                const float mu = ts * (1.f / D), var = fmaxf(tq * (1.f / D) - mu * mu, 0.f), rstd = rsqrtf(var + LN_EPS);
#pragma unroll
                for (int h = 0; h < 2; ++h) {
                    const int c8 = h * 512 + lane * 8; float xn[8];
#pragma unroll
                    for (int e = 0; e < 8; ++e) xn[e] = (y[rr][h * 8 + e] - mu) * rstd * gm[h * 8 + e] + bt[h * 8 + e];
                    if (has_next) { float u[8];
#pragma unroll
                        for (int e = 0; e < 8; ++e) u[e] = xn[e] * nsc[h * 8 + e] + nsh[h * 8 + e];
                        store_A(Adst, xlayout, r, c8, u); }
                    else store8f(P->out + (size_t)r * D + c8, xn);
                }
            }
        }
        if (nr == 1 && row2 < rend) row -= 8;
    }
}

constexpr int CG_ROWS = 40;
__device__ void phase_convgate(PP P, int wid, int j) {
    const int tidx = fresh_tid(wid);
    const bf16_t* Pb = (const bf16_t*)(P->ws + WS_BIG);
    bf16_t* A = (bf16_t*)P->out;
    const float* cw = P->in[11] + (size_t)j * 3 * D, *cb = P->in[12] + (size_t)j * D;
    const int wv = tidx >> 6, lane = tidx & 63;
    const int nunits = (MT / CG_ROWS) * 2;
    for (int unit = blockIdx.x * 8 + wv; unit < nunits; unit += gridDim.x * 8) {
        const int half = unit & 1, t0 = (unit >> 1) * CG_ROWS, c8 = half * 512 + lane * 8;
        float w0[8], w1[8], w2[8], bb[8], qp[8], qc[8], qn[8];
        load8f(cw + c8, w0); load8f(cw + D + c8, w1); load8f(cw + 2 * D + c8, w2); load8f(cb + c8, bb);
        const bf16_t* row = Pb + (size_t)t0 * 2048 + c8;
        if (t0 > 0) unpack8(*(const u32x4*)(row - 2048), qp);
        else {
#pragma unroll
            for (int e = 0; e < 8; ++e) qp[e] = 0.f; }
        unpack8(*(const u32x4*)(row), qc);
        for (int i = 0; i < CG_ROWS; ++i, row += 2048) {
            const int l = (t0 + i) & (SEQL - 1);
            float bg[8], o[8];
            unpack8(*(const u32x4*)(row + D), bg);
            if (t0 + i + 1 < MT) unpack8(*(const u32x4*)(row + 2048), qn);
            else {
#pragma unroll
                for (int e = 0; e < 8; ++e) qn[e] = 0.f; }
            const float mp = l > 0 ? 1.f : 0.f, mn = l < SEQL - 1 ? 1.f : 0.f;
#pragma unroll
            for (int e = 0; e < 8; ++e) { o[e] = bg[e] * (bb[e] + w0[e] * (mp * qp[e]) + w1[e] * qc[e] + w2[e] * (mn * qn[e])); qp[e] = qc[e]; qc[e] = qn[e]; }
            *(u32x4*)(A + (size_t)(t0 + i) * D + c8) = pack8(o);
        }
    }
}

__device__ void phase_ffn_fix(PP P, int wid, int layer) {
    const int tidx = fresh_tid(wid);
    const bf16_t* eb = (const bf16_t*)(P->ws + WS_EB);
    bf16_t* G = (bf16_t*)(P->ws + WS_BIG);
    const float* cw = P->in[24] + (size_t)layer * 3 * F2;
    for (int it = blockIdx.x * NTHREADS + tidx; it < NQ * 2 * 352; it += gridDim.x * NTHREADS) {
        const int c8 = (it % 352) * 8, qs = it / 352, q = qs >> 1, sd = qs & 1;
        const int row = q * 64 + (sd ? 63 : 0), l = row & (SEQL - 1);
        const int cg = c8 >> 3;
        const bf16_t* me = eb + ((size_t)((q * 2 + sd) * 352 + cg) * 4) * 8;
        float pa[8], pv[8];
        unpack8(*(const u32x4*)(me + 16), pa); unpack8(*(const u32x4*)(me + 24), pv);
        const bool has_nb = sd ? (l < SEQL - 1) : (l > 0);
        if (has_nb) {
            const bf16_t* nb = eb + ((size_t)(((sd ? q + 1 : q - 1) * 2 + (sd ? 0 : 1)) * 352 + cg) * 4) * 8;
            float ra[8], rv[8], wa[8], wv[8];
            unpack8(*(const u32x4*)(nb), ra); unpack8(*(const u32x4*)(nb + 8), rv);
            load8f(cw + (sd ? 2 : 0) * F2 + c8, wa); load8f(cw + (sd ? 2 : 0) * F2 + F + c8, wv);
#pragma unroll
            for (int e = 0; e < 8; ++e) { pa[e] += wa[e] * ra[e]; pv[e] += wv[e] * rv[e]; }
        }
        float o[8];
#pragma unroll
        for (int e = 0; e < 8; ++e) o[e] = gelu_tanh(pa[e]) * pv[e];
        *(u32x4*)(G + (size_t)row * F + c8) = pack8(o);
    }
}

__device__ __forceinline__ void scan_thread(PP P, int j, int seq, int g, int k, int p) {
    const bf16_t* E = (const bf16_t*)(P->ws + WS_A);
    bf16_t* X = (bf16_t*)(P->ws + WS_BIG);
    const size_t pbase = ((size_t)(j * 2 + k) * NG + g);
    const float dt = expf(P->in[16][pbase]);
    const float lr = P->in[14][pbase * 64 + p], li = P->in[15][pbase * 64 + p];
    const float mag = expf(lr * dt * (float)TCH), ang = li * dt * (float)TCH;
    const float ar = mag * cosf(ang), ai = mag * sinf(ang);
    float sr = 0.f, si = 0.f;
    const size_t rbase = (size_t)g * XR + (size_t)seq * NCHUNK;
    for (int cb = 0; cb < NCHUNK; cb += 8) {
        float er[8], ei[8];
#pragma unroll
        for (int q = 0; q < 8; ++q) { const int c = k == 0 ? cb + q : NCHUNK - 1 - (cb + q); const size_t r = rbase + c;
            er[q] = __uint_as_float((unsigned)E[r * 256 + k * 128 + p] << 16); ei[q] = __uint_as_float((unsigned)E[r * 256 + k * 128 + 64 + p] << 16); }
#pragma unroll
        for (int q = 0; q < 8; ++q) { const int c = k == 0 ? cb + q : NCHUNK - 1 - (cb + q); const size_t r = rbase + c;
            X[r * XLD + 512 + k * 128 + p] = (bf16_t)(cvt_pk_bf16(sr, 0.f) & 0xffffu);
            X[r * XLD + 512 + k * 128 + 64 + p] = (bf16_t)(cvt_pk_bf16(si, 0.f) & 0xffffu);
            const float nr = ar * sr - ai * si + er[q], ni = ar * si + ai * sr + ei[q];
            sr = nr; si = ni; }
    }
}
__device__ void phase_scan_local(PP P, int wid, int j) {
    const int tidx = fresh_tid(wid);
    StaticOrder S; S.init(NG * XR / BM, 1, gridDim.x, blockIdx.x);
    Unit u;
    for (int i = 0; S.next(i, u); ++i) {
        const int g = u.pm / (XR / BM), pml = u.pm - g * (XR / BM);
        scan_thread(P, j, pml * 4 + (tidx >> 7), g, (tidx >> 6) & 1, tidx & 63);
    }
}

#define XB_TMO      128
#define XB_XCNT(j)  (256  + 64 * (j))
#define XB_XSUB(j)  (1280 + 64 * (j))
#define XB_XGEN(j)  (2304 + 64 * (j))
#define XB_TOP      3328
#define XB_TOPGEN   3392
#define XCD_BAR_WORDS 3456
#define XB_SPIN_CAP (1u << 18)
__device__ __forceinline__ unsigned xb_ld(unsigned* p)              { return __hip_atomic_load(p, __ATOMIC_RELAXED, __HIP_MEMORY_SCOPE_AGENT); }
__device__ __forceinline__ unsigned xb_add(unsigned* p, unsigned v) { return __hip_atomic_fetch_add(p, v, __ATOMIC_RELAXED, __HIP_MEMORY_SCOPE_AGENT); }
__device__ __forceinline__ unsigned xb_xcc_id() { return (unsigned)__builtin_amdgcn_s_getreg((3 << 11) | 20) & 0xFu; }
#define XB_SPIN(cond, bar) do { unsigned _sp = 0; while (cond) { __builtin_amdgcn_s_sleep(1); \
    if ((++_sp & 255u) == 0u) { if (xb_ld(&(bar)[XB_TMO])) break; if (_sp > XB_SPIN_CAP) { atomicAdd(&(bar)[XB_TMO], 1u); break; } } } } while (0)
struct XcdBarrier { unsigned* bar; unsigned x; volatile LAS unsigned* st; };
__device__ __forceinline__ XcdBarrier xcd_barrier_post(unsigned* bar, volatile LAS unsigned* st) {
    XcdBarrier b; b.bar = bar; b.x = xb_xcc_id(); b.st = st;
    if (threadIdx.x == 0) (void)xb_add(&bar[XB_XCNT(b.x)], 1u);
    return b;
}
__device__ __forceinline__ void xcd_barrier_complete(unsigned* bar, unsigned x, unsigned& nloc, unsigned& nx) {
    const unsigned G = gridDim.x * gridDim.y * gridDim.z;
    unsigned sum, cnt, mine, sp = 0u;
    for (;;) {
        sum = 0u; cnt = 0u; mine = 0u;
#pragma unroll
        for (unsigned j = 0; j < 16; ++j) { const unsigned c = xb_ld(&bar[XB_XCNT(j)]); sum += c; cnt += (c > 0u) ? 1u : 0u; mine = (j == x) ? c : mine; }
        if (sum == G) break;
        __builtin_amdgcn_s_sleep(1);
        if ((++sp & 255u) == 0u) { if (xb_ld(&bar[XB_TMO])) break; if (sp > XB_SPIN_CAP) { atomicAdd(&bar[XB_TMO], 1u); break; } }
    }
    nloc = mine > 0u ? mine : 1u; nx = cnt > 0u ? cnt : 1u;
}
__device__ __forceinline__ void xcd_barrier(int wid, LAS unsigned char* lds) {
    asm volatile("s_waitcnt vmcnt(0)" ::: "memory");
    __syncthreads();
    if (wid == 0 && fresh_lane() == 0) {
        PP P = (PP)__builtin_amdgcn_kernarg_segment_ptr(); asm volatile("" : "+s"(P));
        XcdBarrier b; b.bar = (unsigned*)(P->ws + WS_BAR); b.x = xb_xcc_id(); b.st = (volatile LAS unsigned*)(lds + LDS_STAGE);
        unsigned* bar = b.bar;
        __builtin_amdgcn_s_waitcnt(0);
        unsigned nloc = b.st[0], nx = b.st[1];
        if (nloc == 0u) { xcd_barrier_complete(bar, b.x, nloc, nx); b.st[0] = nloc; b.st[1] = nx; }
        const unsigned old = xb_add(&bar[XB_XSUB(b.x)], 1u);
        const unsigned gen = old / nloc;
        if (old + 1u == (gen + 1u) * nloc) {
            __builtin_amdgcn_fence(__ATOMIC_RELEASE, "agent");
            asm volatile("s_waitcnt vmcnt(0)" ::: "memory");
            const unsigned og = xb_add(&bar[XB_TOP], 1u);
            const unsigned tg = og / nx;
            if (og + 1u == (tg + 1u) * nx) xb_add(&bar[XB_TOPGEN], 1u);
            else XB_SPIN(xb_ld(&bar[XB_TOPGEN]) == tg, bar);
            __builtin_amdgcn_fence(__ATOMIC_ACQUIRE, "agent");
            xb_add(&bar[XB_XGEN(b.x)], 1u);
            asm volatile("s_waitcnt vmcnt(0)" ::: "memory");
        } else {
            XB_SPIN(xb_ld(&bar[XB_XGEN(b.x)]) == gen, bar);
            __builtin_amdgcn_fence(__ATOMIC_ACQUIRE, "agent");
            asm volatile("s_waitcnt vmcnt(0)" ::: "memory");
        }
    }
    __syncthreads();
}

#define PROBE 0
__global__ void __launch_bounds__(NTHREADS, 2) fwd_megakernel(Params Parg) {
    extern __shared__ __attribute__((aligned(16))) unsigned char lds_raw[];
    LAS unsigned char* lds = (LAS unsigned char*)lds_raw;
    cg::grid_group grid = cg::this_grid();
    const int wid = __builtin_amdgcn_readfirstlane((int)threadIdx.x >> 6);
    volatile LAS unsigned* xb_st = (volatile LAS unsigned*)(lds + LDS_STAGE);
    if (threadIdx.x == 0) { xb_st[0] = 0u; xb_st[1] = 0u; xb_st[2] = 0u; xb_st[3] = 0u; }
    __syncthreads();
    { PP P0 = (PP)__builtin_amdgcn_kernarg_segment_ptr(); (void)xcd_barrier_post((unsigned*)(P0->ws + WS_BAR), xb_st); }
    {
        PP P = (PP)__builtin_amdgcn_kernarg_segment_ptr(); asm volatile("" : "+s"(P));
        for (int rep = 0; rep < (PROBE == 6 ? 2 : 1); ++rep)
        for (int item = blockIdx.x; item < IT_TOTAL; item += gridDim.x) phase0_item(P, wid, lds, item);
    }
    grid.sync();
    {
        PP P = (PP)__builtin_amdgcn_kernarg_segment_ptr(); asm volatile("" : "+s"(P));
        phase_ymat_toeplitz(P, wid);
        phase_modulate0(P, wid);
    }
    xcd_barrier(wid, lds);

    for (int layer = 0; layer < DEPTH; ++layer) {
        const int j = layer >> 1, mix = layer & 1, nmix = mix ? 5 : 4;
        for (int st = 0; st < nmix + 4; ++st) {
            PP P = (PP)__builtin_amdgcn_kernarg_segment_ptr(); asm volatile("" : "+s"(P));
            unsigned char* ws = P->ws;
            int kind = 0; GemmD g; EpiG e; int rsub = 0;
            const bf16_t* rusrc = (const bf16_t*)(ws + WS_A); const bf16_t* rsrc = (const bf16_t*)(ws + WS_BIG); bf16_t* rdst = (bf16_t*)(ws + WS_A);
            g.tilesPerBatch = 1 << 30; g.bBatchStride = 0; g.lda = D; g.ldb = D; g.K = D; g.nM = MT / BM; g.nN = 4; g.A = (const bf16_t*)(ws + WS_A); g.Bt = nullptr;
            e.kind = 0; e.O = ws + WS_BIG; e.ldc = D; e.layer = layer; e.first = 0; e.wid = wid; e.lds = lds;
            if (st < nmix) {
                if (!mix) {
                    if (st == 0) { g.Bt = (const bf16_t*)(ws + WS_WIN + j * SZ_WIN); g.nN = 3072 / BM; e.kind = 6; }
                    else if (st == 1) kind = 1;
                    else if (st == 2) { g.A = (const bf16_t*)P->out; g.Bt = (const bf16_t*)(ws + WS_WOUT + j * SZ_WOUT); }
                    else { kind = 2; rsub = 0; }
                } else {
                    if (st == 0) { g.A = (const bf16_t*)(ws + WS_BIG); g.Bt = (const bf16_t*)(ws + WS_EMAT + j * SZ_EMAT); g.lda = XLD; g.ldb = 512; g.K = 512; g.nM = NG * XR / BM; g.nN = 1; g.tilesPerBatch = XR / BM; g.bBatchStride = (size_t)256 * 512;
                        e.kind = 0; e.ldc = 256; e.O = ws + WS_A; }
                    else if (st == 1) kind = 3;
                    else if (st == 2) { g.A = (const bf16_t*)(ws + WS_BIG); g.Bt = (const bf16_t*)(ws + WS_YMAT + j * SZ_YMAT); g.lda = XLD; g.ldb = XLD; g.K = XLD; g.nM = NG * XR / BM; g.nN = 2; g.tilesPerBatch = XR / BM; g.bBatchStride = (size_t)512 * XLD;
                        e.kind = 2; e.O = ws + WS_A; }
                    else if (st == 3) { g.Bt = (const bf16_t*)(ws + WS_WGLU + j * SZ_WGLU); g.nN = 2048 / BM; e.kind = 5; e.O = P->out; }
                    else { kind = 2; rsub = 0; rusrc = (const bf16_t*)(ws + WS_BIG); rsrc = (const bf16_t*)P->out; }
                }
            } else {
                const int f = st - nmix;
                unsigned char* mbuf = layer == DEPTH - 1 ? ws + WS_DEAD : (unsigned char*)P->out;
                if (f == 0) { g.Bt = (const bf16_t*)(ws + WS_WUP + layer * SZ_WUP); g.nN = F2 / BM; e.kind = 3; }
                else if (f == 1) kind = 4;
                else if (f == 2) { g.A = (const bf16_t*)(ws + WS_BIG); g.Bt = (const bf16_t*)(ws + WS_WDN + layer * SZ_WDN); g.lda = F; g.ldb = F; g.K = F; e.O = mbuf; }
                else { kind = 2; rsub = 1; rsrc = (const bf16_t*)mbuf; if (layer + 1 < DEPTH && ((layer + 1) & 1)) rdst = (bf16_t*)(ws + WS_BIG); }
            }
            int reps = 1;
            if (PROBE == 1 && kind == 0) reps = 2;
            if (PROBE == 4 && kind == 0 && e.kind == 0) reps = 2;
            if (PROBE == 5 && kind == 0 && e.kind == 3) reps = 2;
            if (PROBE == 2 && kind != 0 && kind != 2) reps = 2;
            for (int rep = 0; rep < reps; ++rep) {
            if (kind == 0) gemm_phase(lds, g, e);
            else if (kind == 1) phase_convgate(P, wid, j);
            else if (kind == 2) phase_resid_ln(P, wid, layer, rsub, rusrc, rsrc, rdst);
            else if (kind == 3) phase_scan_local(P, wid, j);
            else phase_ffn_fix(P, wid, layer);
            if (!(mix && st == 0)) xcd_barrier(wid, lds);
            }
            if (PROBE == 3) { xcd_barrier(wid, lds); xcd_barrier(wid, lds); }
        }
    }
}

extern "C" void kernel_launch(void* const* d_in, const int* in_sizes, int n_in, void* d_out, int out_size, void* d_ws, size_t ws_size, hipStream_t stream) {
    static int grid_blocks = 0;
    if (grid_blocks == 0) {
        if (n_in != 27 || ws_size < WS_TOTAL) { fprintf(stderr, "kernel_launch: need 27 inputs and %zu bytes of workspace (got %d, %zu)\n", (size_t)WS_TOTAL, n_in, ws_size); grid_blocks = -1; return; }
        int dev = 0, cus = 0, per_cu = 0;
        hipGetDevice(&dev);
        hipDeviceGetAttribute(&cus, hipDeviceAttributeMultiprocessorCount, dev);
        if (hipFuncSetAttribute((const void*)fwd_megakernel, hipFuncAttributeMaxDynamicSharedMemorySize, LDS_BYTES) != hipSuccess) { fprintf(stderr, "hipFuncSetAttribute failed\n"); grid_blocks = -1; return; }
        hipOccupancyMaxActiveBlocksPerMultiprocessor(&per_cu, (const void*)fwd_megakernel, NTHREADS, LDS_BYTES);
        if (per_cu < 1) { fprintf(stderr, "occupancy query says %d blocks per CU\n", per_cu); per_cu = 1; }
        grid_blocks = cus * 1;
        (void)hipGetLastError();
    }
    if (grid_blocks < 0) return;
    if (hipMemsetAsync((char*)d_ws + WS_BAR, 0, 16384, stream) != hipSuccess) { fprintf(stderr, "memset of barrier words failed\n"); return; }
    Params p{};
    for (int i = 0; i < 27; ++i) p.in[i] = (const float*)d_in[i];
    p.out = (float*)d_out; p.ws = (unsigned char*)d_ws;
    void* args[] = {&p};
    hipError_t e = hipLaunchCooperativeKernel((const void*)fwd_megakernel, dim3(grid_blocks), dim3(NTHREADS), args, LDS_BYTES, stream);
    if (e != hipSuccess) fprintf(stderr, "cooperative launch failed: %s (grid %d)\n", hipGetErrorString(e), grid_blocks);
}
```

```cpp
#include <hip/hip_runtime.h>
#include <hip/hip_cooperative_groups.h>
#include <cstdio>
namespace cg = cooperative_groups;

#define LAS __attribute__((address_space(3)))
typedef unsigned short bf16_t;
typedef short bf16x8 __attribute__((ext_vector_type(8)));
typedef float f32x4 __attribute__((ext_vector_type(4)));
typedef unsigned u32x4 __attribute__((ext_vector_type(4)));
typedef unsigned u32x2 __attribute__((ext_vector_type(2)));
typedef float f32x2 __attribute__((ext_vector_type(2)));

constexpr int D = 1024, F = 2816, F2 = 5632, MT = 81920, NSEQ = 40, SEQL = 2048, NPROMPT_ROWS = 65536;
constexpr int DEPTH = 4;
constexpr int TCH = 32, NCHUNK = 64, XR = NSEQ * NCHUNK  , XLD = 768, NG = 64;
constexpr float ALPHA = 1.681792830507429f;
constexpr float LN_EPS = 1e-5f;
constexpr int NTHREADS = 512;
constexpr int LDS_STAGE = 131072, LDS_CW = LDS_STAGE + 16, LDS_BYTES = LDS_CW + 8 * 1024;

constexpr size_t SZ_WIN = (size_t)3072 * 1024 * 2, SZ_WOUT = (size_t)1024 * 1024 * 2, SZ_WGLU = (size_t)2048 * 1024 * 2;
constexpr size_t SZ_WUP = (size_t)F2 * 1024 * 2, SZ_WDN = (size_t)1024 * F * 2;
constexpr size_t SZ_EMAT = (size_t)NG * 256 * 512 * 2, SZ_YMAT = (size_t)NG * 512 * XLD * 2, SZ_KTAB = (size_t)NG * 2 * 32 * 256 * 4;
constexpr size_t WS_WIN = 0;
constexpr size_t WS_WOUT = WS_WIN + 2 * SZ_WIN;
constexpr size_t WS_WGLU = WS_WOUT + 2 * SZ_WOUT;
constexpr size_t WS_EMAT = WS_WGLU + 2 * SZ_WGLU;
constexpr size_t WS_YMAT = WS_EMAT + 2 * SZ_EMAT;
constexpr size_t WS_KTAB = WS_YMAT + 2 * SZ_YMAT;
constexpr size_t WS_WUP = WS_KTAB + 2 * SZ_KTAB;
constexpr size_t WS_WDN = WS_WUP + 4 * SZ_WUP;
constexpr size_t WS_MOD = WS_WDN + 4 * SZ_WDN;
constexpr size_t WS_DEAD = 0;
static_assert(WS_WUP - WS_DEAD >= (size_t)MT * D * 2, "the dead-weights region must hold one bf16 [MT][D] tensor");
constexpr size_t WS_STAT = WS_MOD + (size_t)DEPTH * NSEQ * 6 * D * 4;
constexpr size_t WS_A = WS_STAT + (size_t)MT * 2 * 4;
constexpr size_t WS_EB = WS_A + (size_t)MT * D * 2;
constexpr size_t WS_BIG = WS_A + (size_t)NG * XR * XLD * 2;
constexpr size_t BIG_Z = (size_t)NG * XR * 256 * 4;
constexpr size_t WS_END = WS_BIG + (size_t)MT * 3072 * 2;
constexpr size_t WS_BAR = (WS_END + 255) / 256 * 256, WS_TOTAL = WS_BAR + 16384;
constexpr int NQ = MT / 64;
static_assert((size_t)NQ * 2 * 2 * F2 * 2 <= (size_t)NG * XR * XLD * 2 - (size_t)MT * D * 2, "edge buffer must fit in the A spare");
static_assert((size_t)MT * F * 2 <= (size_t)MT * 3072 * 2, "gbuf fits BIG");

struct Params {
    const float* in[27];
    float* out;
    unsigned char* ws;
};
typedef const __attribute__((address_space(4))) Params* PP;

__device__ __forceinline__ int fresh_lane() { int l; asm volatile("v_mbcnt_lo_u32_b32 %0, -1, 0\n\tv_mbcnt_hi_u32_b32 %0, -1, %0" : "=v"(l)); return l; }
__device__ __forceinline__ int fresh_tid(int wid) { return wid * 64 + fresh_lane(); }
__device__ __forceinline__ float wave_sum_dpp(float v) {
    v += __builtin_bit_cast(float, __builtin_amdgcn_update_dpp(0, __builtin_bit_cast(int, v), 0x111, 0xf, 0xf, true));
    v += __builtin_bit_cast(float, __builtin_amdgcn_update_dpp(0, __builtin_bit_cast(int, v), 0x112, 0xf, 0xf, true));
    v += __builtin_bit_cast(float, __builtin_amdgcn_update_dpp(0, __builtin_bit_cast(int, v), 0x114, 0xf, 0xf, true));
    v += __builtin_bit_cast(float, __builtin_amdgcn_update_dpp(0, __builtin_bit_cast(int, v), 0x118, 0xf, 0xf, true));
    v += __builtin_bit_cast(float, __builtin_amdgcn_update_dpp(0, __builtin_bit_cast(int, v), 0x142, 0xa, 0xf, false));
    v += __builtin_bit_cast(float, __builtin_amdgcn_update_dpp(0, __builtin_bit_cast(int, v), 0x143, 0xc, 0xf, false));
    return __builtin_bit_cast(float, __builtin_amdgcn_readlane(__builtin_bit_cast(int, v), 63));
}
__device__ __forceinline__ float xor_shfl(float x, int lane, int o) { return __builtin_bit_cast(float, __builtin_amdgcn_ds_bpermute((lane ^ o) << 2, __builtin_bit_cast(int, x))); }
__device__ __forceinline__ unsigned cvt_pk_bf16(float lo, float hi) { unsigned r; asm volatile("v_cvt_pk_bf16_f32 %0, %1, %2" : "=v"(r) : "v"(lo), "v"(hi)); return r; }
__device__ __forceinline__ void unpack8(const u32x4 v, float (&f)[8]) {
#pragma unroll
    for (int i = 0; i < 4; ++i) { f[2 * i] = __uint_as_float(v[i] << 16); f[2 * i + 1] = __uint_as_float(v[i] & 0xffff0000u); }
}
__device__ __forceinline__ u32x4 pack8(const float (&f)[8]) {
    u32x4 r;
#pragma unroll
    for (int i = 0; i < 4; ++i) r[i] = cvt_pk_bf16(f[2 * i], f[2 * i + 1]);
    return r;
}
__device__ __forceinline__ float gelu_tanh(float x) { const float z = x * ((x * x) * (-0.10294324f) + (-2.3022082f)); return x * __builtin_amdgcn_rcpf(1.f + __builtin_amdgcn_exp2f(z)); }
__device__ __forceinline__ float sigmoid_f(float x) { return 1.f / (1.f + __expf(-x)); }
__device__ __forceinline__ float dpp_prev(float x) { return __builtin_bit_cast(float, __builtin_amdgcn_mov_dpp(__builtin_bit_cast(int, x), 0x121, 0xf, 0xf, true)); }
__device__ __forceinline__ float dpp_next(float x) { return __builtin_bit_cast(float, __builtin_amdgcn_mov_dpp(__builtin_bit_cast(int, x), 0x12F, 0xf, 0xf, true)); }
__device__ __forceinline__ void conv4(const float (&x)[4], float w0, float w1, float w2, float b, int fr, float (&c)[4]) {
    float R[4], L[4];
#pragma unroll
    for (int m = 0; m < 4; ++m) { R[m] = dpp_prev(x[m]); L[m] = dpp_next(x[m]); }
#pragma unroll
    for (int m = 0; m < 4; ++m) {
        const float pv = fr > 0 ? R[m] : (m > 0 ? R[m > 0 ? m - 1 : 0] : 0.f);
        const float nx = fr < 15 ? L[m] : (m < 3 ? L[m < 3 ? m + 1 : 3] : 0.f);
        c[m] = b + w1 * x[m] + w0 * pv + w2 * nx;
    }
}
__device__ __forceinline__ void load8f(const float* p, float (&f)[8]) {
    const f32x4 a = *(const f32x4*)p, b = *(const f32x4*)(p + 4);
    f[0] = a[0]; f[1] = a[1]; f[2] = a[2]; f[3] = a[3]; f[4] = b[0]; f[5] = b[1]; f[6] = b[2]; f[7] = b[3];
}
__device__ __forceinline__ void store8f(float* p, const float (&f)[8]) {
    *(f32x4*)p = (f32x4){f[0], f[1], f[2], f[3]}; *(f32x4*)(p + 4) = (f32x4){f[4], f[5], f[6], f[7]};
}
__device__ __forceinline__ const float* xin_row(PP P, int row) {
    return row < NPROMPT_ROWS ? P->in[0] + (size_t)row * D : P->in[1] + (size_t)(row - NPROMPT_ROWS) * D;
}

constexpr int BM = 256, BK = 64, HALF = 128, HTB = HALF * BK * 2, NXCD = 8, WGM = 8;
__device__ __forceinline__ int lds_byte(int r, int c) { const int st = (r >> 4) * 2 + (c >> 5), rr = r & 15, cc = c & 31, ob = rr * 64 + cc * 2; return st * 1024 + (ob ^ (((ob >> 9) & 1) << 5)); }
__device__ __forceinline__ void stage_rc(int b, int& R, int& C) { const int st = b / 1024, sb = b % 1024, swz = sb ^ (((sb >> 9) & 1) << 5); R = (st >> 1) * 16 + swz / 64; C = (st & 1) * 32 + (swz % 64) / 2; }
__device__ __forceinline__ int perm32(int rho) { const int n = rho >> 4, i = rho & 15; return 8 * (i >> 2) + 4 * n + (i & 3); }

struct Unit { int pm, pn; };
struct GemmD {
    const bf16_t* A; const bf16_t* Bt;
    int lda, ldb, K, nM, nN, tilesPerBatch;
    size_t bBatchStride;
};
struct StaticOrder {
    int nM, nN, nwg, G, c;
    __device__ void init(int nM_, int nN_, int G_, int c_) { nM = nM_; nN = nN_; nwg = nM * nN; G = G_; c = c_; }
    __device__ bool next(int i, Unit& u) const {
        const long L = (long)i * G + c; if (L >= nwg) return false;
        int wgid = (int)L; { const int q = nwg / NXCD, r = nwg % NXCD, xcd = wgid % NXCD, off = wgid / NXCD; wgid = (xcd < r ? xcd * (q + 1) : r * (q + 1) + (xcd - r) * q) + off; }
        const int nig = WGM * nN, gid = wgid / nig, fm = gid * WGM, gsz = (nM - fm) < WGM ? (nM - fm) : WGM;
        u.pm = fm + ((wgid % nig) % gsz); u.pn = (wgid % nig) / gsz; return true;
    }
};

struct EpiG {
    int kind; void* O; int ldc; int layer; int first; int wid; LAS unsigned char* lds;
    __device__ __forceinline__ bool perm() const { return kind != 1; }
    __device__ __forceinline__ void operator()(const f32x4 (&acc)[2][2][4][2], const Unit& u) const {
        PP P = (PP)__builtin_amdgcn_kernarg_segment_ptr(); asm volatile("" : "+s"(P));
        const int wr = wid >> 2, wc = wid & 3;
#define EPI_LANE() const int lane2 = fresh_lane(), fr = lane2 & 15, fq = lane2 >> 4
        if (kind == 0) {
            EPI_LANE();
            const int row0 = u.pm * BM + wr * 64 + fr, col0 = u.pn * BM + wc * 32 + 8 * fq;
#pragma unroll
            for (int ai = 0; ai < 2; ++ai)
#pragma unroll
                for (int m = 0; m < 4; ++m) {
                    bf16_t* rowp = (bf16_t*)O + (size_t)(row0 + ai * HALF + m * 16) * ldc + col0;
#pragma unroll
                    for (int bj = 0; bj < 2; ++bj) {
                        const f32x4 v0 = acc[ai][bj][m][0], v1 = acc[ai][bj][m][1];
                        u32x4 o; o[0] = cvt_pk_bf16(v0[0], v0[1]); o[1] = cvt_pk_bf16(v0[2], v0[3]); o[2] = cvt_pk_bf16(v1[0], v1[1]); o[3] = cvt_pk_bf16(v1[2], v1[3]);
                        *(u32x4*)(rowp + bj * HALF) = o;
                    }
                }
        } else if (kind == 1) {
            EPI_LANE();
            const int row0 = u.pm * BM + wr * 64 + fr, col0 = u.pn * BM + wc * 32 + 4 * fq;
#pragma unroll
            for (int ai = 0; ai < 2; ++ai)
#pragma unroll
                for (int m = 0; m < 4; ++m) {
                    float* rowp = (float*)O + (size_t)(row0 + ai * HALF + m * 16) * ldc + col0;
#pragma unroll
                    for (int bj = 0; bj < 2; ++bj)
#pragma unroll
                        for (int n = 0; n < 2; ++n) *(f32x4*)(rowp + bj * HALF + n * 16) = acc[ai][bj][m][n];
                }
        } else if (kind == 3) {
            EPI_LANE();
            const float* cw = P->in[24] + (size_t)layer * 3 * F2; const float* cb = P->in[25] + (size_t)layer * F2;
            bf16_t* eb = (bf16_t*)(P->ws + WS_EB);
            const int ch0 = u.pn * 128 + wc * 32 + 8 * fq;
            const float m0 = fr == 0 ? 1.f : 0.f, n0 = 1.f - m0, m15 = fr == 15 ? 1.f : 0.f, n15 = 1.f - m15;
            LAS unsigned char* wl = lds + LDS_CW + wid * 1024;
            { const int a_ = lane2 >> 3, q4 = (lane2 & 7) * 4;
              const float* src = (a_ < 6 ? cw + (a_ >> 1) * F2 : cb) + (a_ & 1) * F + (unsigned)(u.pn * 128 + wc * 32 + q4);
              const f32x4 wv = *(const f32x4*)src;
              *(LAS f32x4*)(wl + lane2 * 16) = wv; }
            asm volatile("s_waitcnt lgkmcnt(0)" ::: "memory");
#pragma unroll
            for (int ai = 0; ai < 2; ++ai) {
                const int rowb = u.pm * BM + ai * HALF + wr * 64, q = rowb >> 6;
                unsigned gq[4][4], pe[2][2][4];
#pragma unroll
                for (int n = 0; n < 2; ++n) {
                    f32x4 W[2][4];
#pragma unroll
                    for (int part = 0; part < 2; ++part)
#pragma unroll
                        for (int k = 0; k < 4; ++k) W[part][k] = *(const LAS f32x4*)(wl + (k * 2 + part) * 128 + (8 * fq + 4 * n) * 4);
#pragma unroll
                    for (int ep = 0; ep < 2; ++ep) {
                        f32x2 cres[2][4];
#pragma unroll
                        for (int part = 0; part < 2; ++part) {
                            const f32x2 w0 = (f32x2){W[part][0][2 * ep], W[part][0][2 * ep + 1]}, w1 = (f32x2){W[part][1][2 * ep], W[part][1][2 * ep + 1]};
                            const f32x2 w2 = (f32x2){W[part][2][2 * ep], W[part][2][2 * ep + 1]}, bb = (f32x2){W[part][3][2 * ep], W[part][3][2 * ep + 1]};
                            const f32x2 w0a = w0 * n0, w0b = w0 * m0, w2a = w2 * n15, w2b = w2 * m15;
                            f32x2 X[4], R[4], L[4];
#pragma unroll
                            for (int m = 0; m < 4; ++m) { X[m] = (f32x2){acc[ai][part][m][n][2 * ep], acc[ai][part][m][n][2 * ep + 1]};
                                R[m] = (f32x2){dpp_prev(X[m].x), dpp_prev(X[m].y)}; L[m] = (f32x2){dpp_next(X[m].x), dpp_next(X[m].y)}; }
#pragma unroll
                            for (int m = 0; m < 4; ++m) {
                                f32x2 c = X[m] * w1 + bb; c = R[m] * w0a + c; c = L[m] * w2a + c;
                                if (m > 0) c = R[m > 0 ? m - 1 : 0] * w0b + c;
                                if (m < 3) c = L[m < 3 ? m + 1 : 3] * w2b + c;
                                cres[part][m] = c;
                            }
                            pe[0][part][n * 2 + ep] = cvt_pk_bf16(cres[part][0].x, cres[part][0].y);
                            pe[1][part][n * 2 + ep] = cvt_pk_bf16(cres[part][3].x, cres[part][3].y);
                            __builtin_amdgcn_sched_barrier(0);
                        }
#pragma unroll
                        for (int m = 0; m < 4; ++m) {
                            const f32x2 a = cres[0][m], v = cres[1][m];
                            const f32x2 t = (a * a) * (-0.10294324f) + (-2.3022082f), z = a * t;
                            f32x2 d; d.x = __builtin_amdgcn_exp2f(z.x) + 1.f; d.y = __builtin_amdgcn_exp2f(z.y) + 1.f;
                            f32x2 r; r.x = __builtin_amdgcn_rcpf(d.x); r.y = __builtin_amdgcn_rcpf(d.y);
                            const f32x2 o = (a * v) * r;
                            gq[m][n * 2 + ep] = cvt_pk_bf16(o.x, o.y);
                        }
                        __builtin_amdgcn_sched_barrier(0);
                    }
                }
                if (fr == 0 || fr == 15) {
                    const bool sel = fr == 15;
                    bf16_t* ep_ = eb + (unsigned)((((q * 2 + (sel ? 1 : 0)) * 352 + (ch0 >> 3)) * 4) * 8);
#pragma unroll
                    for (int part = 0; part < 2; ++part) {
                        float rw[8];
#pragma unroll
                        for (int e = 0; e < 8; ++e) rw[e] = sel ? acc[ai][part][3][e >> 2][e & 3] : acc[ai][part][0][e >> 2][e & 3];
                        *(u32x4*)(ep_ + part * 8) = pack8(rw);
                        *(u32x4*)(ep_ + (2 + part) * 8) = (u32x4){sel ? pe[1][part][0] : pe[0][part][0], sel ? pe[1][part][1] : pe[0][part][1], sel ? pe[1][part][2] : pe[0][part][2], sel ? pe[1][part][3] : pe[0][part][3]};
                    }
                }
#pragma unroll
                for (int m = 0; m < 4; ++m) {
                    const bool edge = (m == 0 && fr == 0) || (m == 3 && fr == 15);
                    if (!edge) *(u32x4*)((bf16_t*)O + (unsigned)((rowb + m * 16 + fr) * F + ch0)) = (u32x4){gq[m][0], gq[m][1], gq[m][2], gq[m][3]};
                }
            }
        } else if (kind == 6) {
            EPI_LANE();
            if (u.pn < 8) {
                const int c0 = u.pn * 128 + wc * 32 + 8 * fq;
#pragma unroll
                for (int ai = 0; ai < 2; ++ai)
#pragma unroll
                    for (int m = 0; m < 4; ++m) {
                        const int row = u.pm * BM + ai * HALF + wr * 64 + m * 16 + fr;
                        float qv[8];
#pragma unroll
                        for (int e = 0; e < 8; ++e) qv[e] = acc[ai][0][m][e >> 2][e & 3] * acc[ai][1][m][e >> 2][e & 3];
                        *(u32x4*)((bf16_t*)O + (unsigned)(row * 2048 + c0)) = pack8(qv);
                    }
            } else {
                const int c0 = D + (u.pn - 8) * BM + wc * 32 + 8 * fq;
#pragma unroll
                for (int ai = 0; ai < 2; ++ai)
#pragma unroll
                    for (int m = 0; m < 4; ++m) {
                        const int row = u.pm * BM + ai * HALF + wr * 64 + m * 16 + fr;
#pragma unroll
                        for (int bj = 0; bj < 2; ++bj) {
                            float bv[8];
#pragma unroll
                            for (int e = 0; e < 8; ++e) bv[e] = acc[ai][bj][m][e >> 2][e & 3];
                            *(u32x4*)((bf16_t*)O + (unsigned)(row * 2048 + c0 + bj * HALF)) = pack8(bv);
                        }
                    }
            }
        } else if (kind == 5) {
            EPI_LANE();
            const int c0 = u.pn * 128 + wc * 32 + 8 * fq;
#pragma unroll
            for (int ai = 0; ai < 2; ++ai)
#pragma unroll
                for (int m = 0; m < 4; ++m) {
                    const int row = u.pm * BM + ai * HALF + wr * 64 + m * 16 + fr;
                    float mv[8];
#pragma unroll
                    for (int e = 0; e < 8; ++e) mv[e] = acc[ai][0][m][e >> 2][e & 3] * __builtin_amdgcn_rcpf(1.f + __builtin_amdgcn_exp2f(-1.4426950409f * acc[ai][1][m][e >> 2][e & 3]));
                    *(u32x4*)((bf16_t*)O + (unsigned)(row * D + c0)) = pack8(mv);
                }
        } else {
            EPI_LANE();
            const int row0 = u.pm * BM + wr * 64 + fr, col0 = u.pn * BM + wc * 32 + 8 * fq;
#pragma unroll
            for (int ai = 0; ai < 2; ++ai)
#pragma unroll
                for (int m = 0; m < 4; ++m) {
                    const int row = row0 + ai * HALF + m * 16, g = row / XR, r = row - g * XR;
#pragma unroll
                    for (int bj = 0; bj < 2; ++bj) {
                        const int col = col0 + bj * HALF, t = col >> 4, i0 = col & 15;
                        const f32x4 v0 = acc[ai][bj][m][0], v1 = acc[ai][bj][m][1];
                        u32x4 o; o[0] = cvt_pk_bf16(gelu_tanh(v0[0]), gelu_tanh(v0[1])); o[1] = cvt_pk_bf16(gelu_tanh(v0[2]), gelu_tanh(v0[3]));
                        o[2] = cvt_pk_bf16(gelu_tanh(v1[0]), gelu_tanh(v1[1])); o[3] = cvt_pk_bf16(gelu_tanh(v1[2]), gelu_tanh(v1[3]));
                        *(u32x4*)((bf16_t*)O + (size_t)(r * TCH + t) * D + g * 16 + i0) = o;
                    }
                }
        }
    }
};

__device__ __forceinline__ void gemm_phase(LAS unsigned char* lds, const GemmD& g, const EpiG& E) {
    const int wid = E.wid, tid = fresh_tid(wid), lane = tid & 63, wr = wid >> 2, wc = wid & 3, fr = lane & 15, fq = lane >> 4;
    const int K = g.K, nt = K / BK;
    StaticOrder S; S.init(g.nM, g.nN, gridDim.x, blockIdx.x);
    unsigned voffA[2], voffB[2];
#pragma unroll
    for (int i = 0; i < 2; ++i) { int R, C; stage_rc(tid * 16 + i * 8192, R, C); const int Rb = E.perm() ? ((R & ~31) + perm32(R & 31)) : R;
        voffA[i] = (unsigned)(R * g.lda + C) * 2u; voffB[i] = (unsigned)(Rb * g.ldb + C) * 2u; }
    const __amdgpu_buffer_rsrc_t rA = __builtin_amdgcn_make_buffer_rsrc((void*)g.A, (short)0, 0x7fffffff, 0x00020000);
    const __amdgpu_buffer_rsrc_t rB = __builtin_amdgcn_make_buffer_rsrc((void*)g.Bt, (short)0, 0x7fffffff, 0x00020000);
    const unsigned kstep = (unsigned)(BK * 2);
    const unsigned hstepA = (unsigned)HALF * g.lda * 2, hstepB = (unsigned)HALF * g.ldb * 2;
    const unsigned tstepA = 2 * hstepA, tstepB = 2 * hstepB;
    const unsigned ldsw = (unsigned)wid * 1024u;
    const int aoff = lds_byte(wr * 64 + fr, fq * 8), boff = lds_byte(wc * 32 + fr, fq * 8);
#define PG8_SA(b, h) (((b) * 2 + (h)) * HTB)
#define PG8_SB(b, h) ((4 + (b) * 2 + (h)) * HTB)
#define PG8_STAGE(bufoff, soff, R, voff) do { _Pragma("unroll") for (int _i = 0; _i < 2; ++_i) \
        __builtin_amdgcn_raw_ptr_buffer_load_lds(R, (LAS unsigned*)(lds + (bufoff) + ldsw + _i * 8192), 16, (int)(voff)[_i], (int)(soff), 0, 0); } while (0)
#define PG8_LDA(dst, b, h) do { _Pragma("unroll") for (int m = 0; m < 4; ++m) _Pragma("unroll") for (int k = 0; k < 2; ++k) dst[m][k] = *(const LAS bf16x8*)(lds + PG8_SA(b, h) + aoff + m * 2048 + k * 1024); } while (0)
#define PG8_LDB(dst, b, h) do { _Pragma("unroll") for (int n = 0; n < 2; ++n) _Pragma("unroll") for (int k = 0; k < 2; ++k) dst[n][k] = *(const LAS bf16x8*)(lds + PG8_SB(b, h) + boff + n * 2048 + k * 1024); } while (0)
#define PG8_MMA(ai, bj, At, Bt) do { __builtin_amdgcn_s_setprio(1); _Pragma("unroll") for (int m = 0; m < 4; ++m) _Pragma("unroll") for (int n = 0; n < 2; ++n) _Pragma("unroll") for (int k = 0; k < 2; ++k) \
        acc[ai][bj][m][n] = __builtin_amdgcn_mfma_f32_16x16x32_bf16(Bt[n][k], At[m][k], acc[ai][bj][m][n], 0, 0, 0); __builtin_amdgcn_s_setprio(0); } while (0)
#define PG8_MMA0(ai, bj, At, Bt) do { __builtin_amdgcn_s_setprio(1); _Pragma("unroll") for (int m = 0; m < 4; ++m) _Pragma("unroll") for (int n = 0; n < 2; ++n) { \
        acc[ai][bj][m][n] = __builtin_amdgcn_mfma_f32_16x16x32_bf16(Bt[n][0], At[m][0], (f32x4){0.f, 0.f, 0.f, 0.f}, 0, 0, 0); \
        acc[ai][bj][m][n] = __builtin_amdgcn_mfma_f32_16x16x32_bf16(Bt[n][1], At[m][1], acc[ai][bj][m][n], 0, 0, 0); } __builtin_amdgcn_s_setprio(0); } while (0)
#define PG8_KBODY(MMA_A) do { \
            const bool last = (t == nt - 2); \
            const unsigned a1 = cA + (unsigned)(t + 1) * kstep; \
            const unsigned a2 = last ? nA : cA + (unsigned)(t + 2) * kstep; const unsigned b2 = last ? nB : cB + (unsigned)(t + 2) * kstep; \
            const unsigned a3 = a2 + kstep; const unsigned b3 = b2 + kstep; \
            PG8_LDB(B0, 0, 0); PG8_SCHED; PG8_LDA(At, 0, 0); PG8_STAGE(PG8_SA(1, 1), a1 + hstepA, rA, voffA); \
            PG8_WAIT_L(8); PG8_BAR; PG8_WAIT_L(0); MMA_A(0, 0, At, B0); PG8_BAR; PG8_SCHED; \
            PG8_LDB(B1, 0, 1); PG8_STAGE(PG8_SB(0, 0), b2, rB, voffB); \
            PG8_BAR; PG8_WAIT_L(0); MMA_A(0, 1, At, B1); PG8_BAR; \
            PG8_LDA(At, 0, 1); PG8_STAGE(PG8_SA(0, 0), a2, rA, voffA); \
            PG8_BAR; PG8_WAIT_L(0); MMA_A(1, 0, At, B0); PG8_BAR; PG8_SCHED; \
            PG8_STAGE(PG8_SB(0, 1), b2 + hstepB, rB, voffB); \
            PG8_WAIT_V(6); PG8_BAR; MMA_A(1, 1, At, B1); PG8_BAR; \
            PG8_LDB(B0, 1, 0); PG8_SCHED; PG8_LDA(At, 1, 0); PG8_STAGE(PG8_SA(0, 1), a2 + hstepA, rA, voffA); \
            PG8_WAIT_L(8); PG8_BAR; PG8_WAIT_L(0); PG8_MMA(0, 0, At, B0); PG8_BAR; PG8_SCHED; \
            PG8_LDB(B1, 1, 1); PG8_STAGE(PG8_SB(1, 0), b3, rB, voffB); \
            PG8_BAR; PG8_WAIT_L(0); PG8_MMA(0, 1, At, B1); PG8_BAR; \
            PG8_LDA(At, 1, 1); PG8_STAGE(PG8_SA(1, 0), a3, rA, voffA); \
            PG8_BAR; PG8_WAIT_L(0); PG8_MMA(1, 0, At, B0); PG8_BAR; PG8_SCHED; \
            PG8_STAGE(PG8_SB(1, 1), b3 + hstepB, rB, voffB); \
            PG8_WAIT_V(6); PG8_BAR; PG8_MMA(1, 1, At, B1); PG8_BAR; \
        } while (0)
#define PG8_WAIT_V(n) asm volatile("s_waitcnt vmcnt(" #n ")" ::: "memory")
#define PG8_WAIT_L(n) asm volatile("s_waitcnt lgkmcnt(" #n ")" ::: "memory")
#define PG8_BAR __builtin_amdgcn_s_barrier()
#define PG8_SCHED __builtin_amdgcn_sched_barrier(0)
    Unit cur, nxt; int ui = 0;
    if (!S.next(0, cur)) return;
    f32x4 acc[2][2][4][2];
    bf16x8 At[4][2], B0[2][2], B1[2][2];
    unsigned cA = (unsigned)cur.pm * tstepA;
    unsigned cB = (unsigned)(((size_t)(cur.pm / g.tilesPerBatch) * g.bBatchStride) * 2) + (unsigned)cur.pn * tstepB;
    PG8_STAGE(PG8_SB(0, 0), cB, rB, voffB); PG8_STAGE(PG8_SA(0, 0), cA, rA, voffA); PG8_STAGE(PG8_SB(0, 1), cB + hstepB, rB, voffB); PG8_STAGE(PG8_SA(0, 1), cA + hstepA, rA, voffA);
    if (wr == 1) PG8_BAR;
    PG8_WAIT_V(4); PG8_BAR;
    PG8_STAGE(PG8_SB(1, 0), cB + kstep, rB, voffB); PG8_STAGE(PG8_SA(1, 0), cA + kstep, rA, voffA); PG8_STAGE(PG8_SB(1, 1), cB + hstepB + kstep, rB, voffB);
    PG8_WAIT_V(6); PG8_BAR;
    for (;;) {
        const bool has_next = S.next(ui + 1, nxt);
        const unsigned nA = has_next ? (unsigned)nxt.pm * tstepA : cA;
        const unsigned nB = has_next ? (unsigned)(((size_t)(nxt.pm / g.tilesPerBatch) * g.bBatchStride) * 2) + (unsigned)nxt.pn * tstepB : cB;
        { const int t = 0; PG8_KBODY(PG8_MMA0); }
        for (int t = 2; t < nt; t += 2) { PG8_KBODY(PG8_MMA); }
        E(acc, cur);
        if (!has_next) break;
        cur = nxt; cA = nA; cB = nB; ++ui;
    }
    PG8_WAIT_V(0);
    if (wr == 0) PG8_BAR;
    PG8_BAR;
#undef PG8_SA
#undef PG8_KBODY
#undef PG8_MMA0
#undef PG8_SB
#undef PG8_STAGE
#undef PG8_LDA
#undef PG8_LDB
#undef PG8_MMA
#undef PG8_WAIT_V
#undef PG8_WAIT_L
#undef PG8_BAR
#undef PG8_SCHED
}

__device__ __forceinline__ void transpose_tile4(int wid, LAS float* tile, const float* src, bf16_t* dst, int K, int N, int k0, int nt4, int pair) {
    const int t = fresh_tid(wid);
    { const int row = t >> 3, c8 = (t & 7) * 8;
#pragma unroll
      for (int q = 0; q < 4; ++q) { const int nt = nt4 * 4 + q, n0src = pair > 0 ? ((nt >> 1) & 1) * pair + (nt >> 2) * 128 + (nt & 1) * 64 : pair < 0 ? (nt < 32 ? D + ((nt >> 1) & 1) * D + (nt >> 2) * 128 + (nt & 1) * 64 : (nt - 32) * 64) : nt * 64;
          float f[8]; load8f(src + (size_t)(k0 + row) * N + n0src + c8, f);
#pragma unroll
          for (int e = 0; e < 8; ++e) tile[q * 4160 + row * 65 + c8 + e] = f[e]; } }
    __syncthreads();
    { const int n = t >> 3, k8 = (t & 7) * 8;
#pragma unroll
      for (int q = 0; q < 4; ++q) { float f[8];
#pragma unroll
          for (int e = 0; e < 8; ++e) f[e] = tile[q * 4160 + (k8 + e) * 65 + n];
          *(u32x4*)(dst + (size_t)(nt4 * 256 + q * 64 + n) * K + k0 + k8) = pack8(f); } }
    __syncthreads();
}

constexpr int NT_WIN = 2 * 16 * 12, NT_WOUT = 2 * 16 * 4, NT_WGLU = 2 * 16 * 8, NT_WUP = 4 * 16 * 22, NT_WDN = 4 * 44 * 4;
constexpr int IT_ADA = DEPTH * (6 * D / 128);
constexpr int IT_S5 = 2 * NG * 2;
constexpr int IT_TR0 = IT_ADA + IT_S5;
constexpr int IT_TOTAL = IT_TR0 + NT_WIN + NT_WOUT + NT_WGLU + NT_WUP + NT_WDN;

__device__ void phase0_item(PP P, int wid, LAS unsigned char* lds, int item) {
    const int tid = fresh_tid(wid);
    if (item < IT_ADA) {
        const int layer = item / 48, nb = item % 48, col = nb * 128 + (tid & 127), bg = tid >> 7;
        LAS float* cs = (LAS float*)lds;
        const float* W = P->in[4] + (size_t)layer * D * 6 * D;
        float acc[10];
#pragma unroll
        for (int i = 0; i < 10; ++i) acc[i] = 0.f;
        for (int kc = 0; kc < 4; ++kc) {
            __syncthreads();
            for (int e = tid; e < 40 * 256; e += NTHREADS) { const int b = e >> 8, k = kc * 256 + (e & 255);
                const float c = b < 32 ? P->in[2][b * D + k] : P->in[3][(b - 32) * D + k]; cs[e] = c / (1.f + __expf(-c)); }
            __syncthreads();
            for (int k = 0; k < 256; k += 4) {
                const float* wp = W + (size_t)(kc * 256 + k) * (6 * D) + col;
                const float w0 = wp[0], w1 = wp[6 * D], w2 = wp[2 * 6 * D], w3 = wp[3 * 6 * D];
#pragma unroll
                for (int i = 0; i < 10; ++i) { const f32x4 c4 = *(const LAS f32x4*)(cs + (bg * 10 + i) * 256 + k); acc[i] += c4[0] * w0 + c4[1] * w1 + c4[2] * w2 + c4[3] * w3; } }
        }
        const float bias = P->in[5][layer * 6 * D + col];
        float* mod = (float*)(P->ws + WS_MOD);
#pragma unroll
        for (int i = 0; i < 10; ++i) mod[((size_t)layer * NSEQ + bg * 10 + i) * (6 * D) + col] = acc[i] + bias;
        __syncthreads();
        return;
    }
    item -= IT_ADA;
    if (item < IT_S5) {
        const int j = item >> 7, g = (item >> 1) & 63, k = item & 1;
        LAS float* pwr = (LAS float*)lds;
        LAS float* pwi = pwr + 33 * 64;
        LAS float* Cre = pwi + 33 * 64;
        LAS float* Cim = Cre + 16 * 64;
        LAS float* Bbr = Cim + 16 * 64;
        LAS float* Bbi = Bbr + 64 * 16;
        const size_t pbase = ((size_t)(j * 2 + k) * NG + g);
        const float dt = expf(P->in[16][pbase]);
        __syncthreads();
        for (int e = tid; e < 33 * 64; e += NTHREADS) { const int tau = e >> 6, p = e & 63;
            const float lr = P->in[14][pbase * 64 + p], li = P->in[15][pbase * 64 + p];
            const float mag = expf(lr * dt * (float)tau), ang = li * dt * (float)tau;
            pwr[e] = mag * cosf(ang); pwi[e] = mag * sinf(ang); }
        for (int e = tid; e < 1024; e += NTHREADS) { Cre[e] = P->in[19][pbase * 1024 + e]; Cim[e] = P->in[20][pbase * 1024 + e]; }
        __syncthreads();
        for (int e = tid; e < 1024; e += NTHREADS) { const int p = e >> 4;
            const float lr = P->in[14][pbase * 64 + p], li = P->in[15][pbase * 64 + p];
            const float lbr = pwr[64 + p], lbi = pwi[64 + p], den = lr * lr + li * li;
            const float fr_ = ((lbr - 1.f) * lr + lbi * li) / den, fi_ = (lbi * lr - (lbr - 1.f) * li) / den;
            const float br = P->in[17][pbase * 1024 + e], bi = P->in[18][pbase * 1024 + e];
            Bbr[e] = fr_ * br - fi_ * bi; Bbi[e] = fr_ * bi + fi_ * br; }
        __syncthreads();
        float* kt = (float*)(P->ws + WS_KTAB) + ((size_t)(j * NG + g) * 2 + k) * 32 * 256;
        { const int tau = tid >> 4, i = tid & 15;
            float sacc[16];
#pragma unroll
            for (int jj = 0; jj < 16; ++jj) sacc[jj] = 0.f;
            for (int p = 0; p < 64; ++p) { const float cr = Cre[i * 64 + p], ci = Cim[i * 64 + p], pr = pwr[tau * 64 + p], pi = pwi[tau * 64 + p];
                const float xr = cr * pr - ci * pi, xi = cr * pi + ci * pr;
#pragma unroll
                for (int j4 = 0; j4 < 4; ++j4) { const f32x4 br = *(const LAS f32x4*)(Bbr + p * 16 + j4 * 4), bi = *(const LAS f32x4*)(Bbi + p * 16 + j4 * 4);
#pragma unroll
                    for (int q = 0; q < 4; ++q) sacc[j4 * 4 + q] += xr * br[q] - xi * bi[q]; } }
#pragma unroll
            for (int j4 = 0; j4 < 4; ++j4) *(f32x4*)(kt + tau * 256 + i * 16 + j4 * 4) = (f32x4){sacc[j4 * 4], sacc[j4 * 4 + 1], sacc[j4 * 4 + 2], sacc[j4 * 4 + 3]}; }
        bf16_t* em = (bf16_t*)(P->ws + WS_EMAT) + ((size_t)(j * NG + g) * 256 + k * 128) * 512;
        for (int e = tid; e < 128 * 64; e += NTHREADS) { const int n = e >> 6, kk8 = (e & 63) * 8, p = n & 63, im = n >> 6, s = kk8 >> 4, j0 = kk8 & 15;
            const int pw_e = k == 0 ? (TCH - 1 - s) : s; const float pr = pwr[pw_e * 64 + p], pi = pwi[pw_e * 64 + p]; float f[8];
#pragma unroll
            for (int q = 0; q < 8; ++q) { const float br = Bbr[p * 16 + j0 + q], bi = Bbi[p * 16 + j0 + q]; f[q] = im ? (pr * bi + pi * br) : (pr * br - pi * bi); }
            *(u32x4*)(em + (size_t)n * 512 + kk8) = pack8(f); }
        bf16_t* ym = (bf16_t*)(P->ws + WS_YMAT) + (size_t)(j * NG + g) * 512 * XLD + 512 + k * 128;
        for (int e = tid; e < 512 * 16; e += NTHREADS) { const int n = e >> 4, c8 = (e & 15) * 8, t = n >> 4, i = n & 15, im = c8 >> 6, p0 = c8 & 63;
            const int pw_e = k == 0 ? (t + 1) : (TCH - t); float f[8];
#pragma unroll
            for (int q = 0; q < 8; ++q) { const int p = p0 + q; const float cr = Cre[i * 64 + p], ci = Cim[i * 64 + p], pr = pwr[pw_e * 64 + p], pi = pwi[pw_e * 64 + p];
                f[q] = im ? -(cr * pi + ci * pr) : (cr * pr - ci * pi); }
            *(u32x4*)(ym + (size_t)n * XLD + c8) = pack8(f); }
        __syncthreads();
        return;
    }
    item -= IT_S5;
    LAS float* tile = (LAS float*)lds;
    if (item < NT_WIN) { const int l = item / 192, r = item % 192, kt = r / 12, nt4 = r % 12;
        transpose_tile4(wid, tile, P->in[10] + (size_t)l * D * 3072, (bf16_t*)(P->ws + WS_WIN + l * SZ_WIN), D, 3072, kt * 64, nt4, -1); return; }
    item -= NT_WIN;
    if (item < NT_WOUT) { const int l = item / 64, r = item % 64, kt = r / 4, nt4 = r % 4;
        transpose_tile4(wid, tile, P->in[13] + (size_t)l * D * D, (bf16_t*)(P->ws + WS_WOUT + l * SZ_WOUT), D, D, kt * 64, nt4, 0); return; }
    item -= NT_WOUT;
    if (item < NT_WGLU) { const int l = item / 128, r = item % 128, kt = r / 8, nt4 = r % 8;
        transpose_tile4(wid, tile, P->in[22] + (size_t)l * D * 2048, (bf16_t*)(P->ws + WS_WGLU + l * SZ_WGLU), D, 2048, kt * 64, nt4, D); return; }
    item -= NT_WGLU;
    if (item < NT_WUP) { const int l = item / 352, r = item % 352, kt = r / 22, nt4 = r % 22;
        transpose_tile4(wid, tile, P->in[23] + (size_t)l * D * F2, (bf16_t*)(P->ws + WS_WUP + l * SZ_WUP), D, F2, kt * 64, nt4, F); return; }
    item -= NT_WUP;
    { const int l = item / 176, r = item % 176, kt = r / 4, nt4 = r % 4;
        transpose_tile4(wid, tile, P->in[26] + (size_t)l * F * D, (bf16_t*)(P->ws + WS_WDN + l * SZ_WDN), F, D, kt * 64, nt4, 0); }
}

__device__ void phase_ymat_toeplitz(PP P, int wid) {
    const int tidx = fresh_tid(wid);
    const size_t total = (size_t)2 * NG * 512 * 64;
    const float* ktab = (const float*)(P->ws + WS_KTAB);
    for (size_t it = (size_t)blockIdx.x * NTHREADS + tidx; it < total; it += (size_t)gridDim.x * NTHREADS) {
        const int k8 = (int)(it & 63) * 8, n = (int)(it >> 6) & 511, jg = (int)(it >> 15);
        const int t = n >> 4, i = n & 15, s = k8 >> 4, j0 = k8 & 15;
        const float* kf = ktab + ((size_t)jg * 2 + 0) * 32 * 256, *kb = ktab + ((size_t)jg * 2 + 1) * 32 * 256;
        float f[8];
        if (s < t) { load8f(kf + (t - s) * 256 + i * 16 + j0, f); }
        else if (s > t) { load8f(kb + (s - t) * 256 + i * 16 + j0, f); }
        else { float a[8], b[8]; load8f(kf + i * 16 + j0, a); load8f(kb + i * 16 + j0, b);
            const int j = jg >> 6, g = jg & 63; const float dsk = P->in[21][j * D + g * 16 + i];
#pragma unroll
            for (int q = 0; q < 8; ++q) f[q] = a[q] + b[q] + ((j0 + q) == i ? dsk : 0.f); }
        *(u32x4*)((bf16_t*)(P->ws + WS_YMAT) + ((size_t)jg * 512 + n) * XLD + k8) = pack8(f);
    }
}

__device__ __forceinline__ void store_A(bf16_t* A, bool xlayout, int token, int c8, const float (&u)[8]) {
    if (!xlayout) *(u32x4*)(A + (size_t)token * D + c8) = pack8(u);
    else { const int g = c8 >> 4, i0 = c8 & 15, r = token >> 5, t = token & 31; *(u32x4*)(A + ((size_t)g * XR + r) * XLD + t * 16 + i0) = pack8(u); }
}

__device__ __forceinline__ void load_A(const bf16_t* A, bool xlayout, int token, int c8, float (&u)[8]) {
    if (!xlayout) unpack8(*(const u32x4*)(A + (size_t)token * D + c8), u);
    else { const int g = c8 >> 4, i0 = c8 & 15, r = token >> 5, t = token & 31; unpack8(*(const u32x4*)(A + ((size_t)g * XR + r) * XLD + t * 16 + i0), u); }
}

__device__ void phase_modulate0(PP P, int wid) {
    const int tidx = fresh_tid(wid);
    const float* mod = (const float*)(P->ws + WS_MOD);
    bf16_t* A = (bf16_t*)(P->ws + WS_A);
    for (size_t it = (size_t)blockIdx.x * NTHREADS + tidx; it < (size_t)MT * 128; it += (size_t)gridDim.x * NTHREADS) {
        const int token = (int)(it >> 7), c8 = (int)(it & 127) * 8, seq = token >> 11;
        float x[8], sh[8], sc[8], u[8];
        load8f(xin_row(P, token) + c8, x);
        const float* mrow = mod + (size_t)(0 * NSEQ + seq) * 6 * D;
        load8f(mrow + c8, sh); load8f(mrow + D + c8, sc);
#pragma unroll
        for (int e = 0; e < 8; ++e) u[e] = x[e] * (1.f + sc[e]) + sh[e];
        store_A(A, false, token, c8, u);
    }
}

__device__ void phase_resid_ln(PP P, int wid, int layer, int sub, const bf16_t* usrc, const bf16_t* msrc, bf16_t* Adst) {
    const int tidx = fresh_tid(wid);
    const float* mod = (const float*)(P->ws + WS_MOD);
    const int wv = tidx >> 6, lane = tidx & 63;
    const float* lng = P->in[sub == 0 ? 6 : 8] + layer * D, *lnb = P->in[sub == 0 ? 7 : 9] + layer * D;
    const int nl = sub == 0 ? layer : layer + 1, nsub = sub == 0 ? 1 : 0;
    const bool has_next = nl < DEPTH, xlayout = has_next && nsub == 0 && (nl & 1), x_from_input = layer == 0 && sub == 0;
    const bool src_xlayout = sub == 0 && (layer & 1);
    const int rpw = (MT + (int)gridDim.x - 1) / (int)gridDim.x, rbeg = blockIdx.x * rpw, rend = (rbeg + rpw) < MT ? (rbeg + rpw) : MT;
    float gm[16], bt[16], gt[16], sh[16], sc[16], nsh[16], nsc[16];
#pragma unroll
    for (int h = 0; h < 2; ++h) { float t[8]; load8f(lng + h * 512 + lane * 8, t);
#pragma unroll
        for (int e = 0; e < 8; ++e) gm[h * 8 + e] = t[e];
        load8f(lnb + h * 512 + lane * 8, t);
#pragma unroll
        for (int e = 0; e < 8; ++e) bt[h * 8 + e] = t[e]; }
    int cur_seq = -1;
    for (int row = rbeg + wv; row < rend; row += 16) {
        const int seq = row >> 11;
        if (seq != cur_seq) {
            cur_seq = seq;
            const float* mrow = mod + (size_t)(layer * NSEQ + seq) * 6 * D;
            const float* nmrow = mod + (size_t)((has_next ? nl : 0) * NSEQ + seq) * 6 * D;
#pragma unroll
            for (int h = 0; h < 2; ++h) { const int c8 = h * 512 + lane * 8; float t[8];
                load8f(mrow + (sub == 0 ? 2 : 5) * D + c8, t);
#pragma unroll
                for (int e = 0; e < 8; ++e) gt[h * 8 + e] = 1.f + t[e];
                load8f(mrow + (sub == 0 ? 0 : 3) * D + c8, t);
#pragma unroll
                for (int e = 0; e < 8; ++e) sh[h * 8 + e] = t[e];
                load8f(mrow + (sub == 0 ? 1 : 4) * D + c8, t);
#pragma unroll
                for (int e = 0; e < 8; ++e) sc[h * 8 + e] = __builtin_amdgcn_rcpf(1.f + t[e]);
                load8f(nmrow + (nsub == 0 ? 0 : 3) * D + c8, t);
#pragma unroll
                for (int e = 0; e < 8; ++e) nsh[h * 8 + e] = t[e];
                load8f(nmrow + (nsub == 0 ? 1 : 4) * D + c8, t);
#pragma unroll
                for (int e = 0; e < 8; ++e) nsc[h * 8 + e] = 1.f + t[e]; }
        }
        const int row2 = row + 8;
        const int nr = (row2 < rend && (row2 >> 11) == seq) ? 2 : 1;
        float y[2][16], sum[2] = {0.f, 0.f}, sq[2] = {0.f, 0.f};
#pragma unroll
        for (int rr = 0; rr < 2; ++rr) {
            if (rr < nr) {
                const int r = row + rr * 8;
#pragma unroll
                for (int h = 0; h < 2; ++h) {
                    const int c8 = h * 512 + lane * 8; float x[8], m[8];
                    if (x_from_input) load8f(xin_row(P, r) + c8, x);
                    else { float u[8]; load_A(usrc, src_xlayout, r, c8, u);
#pragma unroll
                        for (int e = 0; e < 8; ++e) x[e] = (u[e] - sh[h * 8 + e]) * sc[h * 8 + e]; }
                    unpack8(*(const u32x4*)(msrc + (size_t)r * D + c8), m);
#pragma unroll
                    for (int e = 0; e < 8; ++e) { const float v = ALPHA * x[e] + gt[h * 8 + e] * m[e]; y[rr][h * 8 + e] = v; sum[rr] += v; sq[rr] += v * v; }
                }
            }
        }
#pragma unroll
        for (int rr = 0; rr < 2; ++rr) {
            if (rr < nr) {
                const int r = row + rr * 8;
                const float ts = wave_sum_dpp(sum[rr]), tq = wave_sum_dpp(sq[rr]);
                const float mu = ts * (1.f / D), var = fmaxf(tq * (1.f / D) - mu * mu, 0.f), rstd = rsqrtf(var + LN_EPS);
#pragma unroll
                for (int h = 0; h < 2; ++h) {
                    const int c8 = h * 512 + lane * 8; float xn[8];
#pragma unroll
                    for (int e = 0; e < 8; ++e) xn[e] = (y[rr][h * 8 + e] - mu) * rstd * gm[h * 8 + e] + bt[h * 8 + e];
                    if (has_next) { float u[8];
#pragma unroll
                        for (int e = 0; e < 8; ++e) u[e] = xn[e] * nsc[h * 8 + e] + nsh[h * 8 + e];
                        store_A(Adst, xlayout, r, c8, u); }
                    else store8f(P->out + (size_t)r * D + c8, xn);
                }
            }
        }
        if (nr == 1 && row2 < rend) row -= 8;
    }
}

constexpr int CG_ROWS = 40;
__device__ void phase_convgate(PP P, int wid, int j) {
    const int tidx = fresh_tid(wid);
    const bf16_t* Pb = (const bf16_t*)(P->ws + WS_BIG);
    bf16_t* A = (bf16_t*)P->out;
    const float* cw = P->in[11] + (size_t)j * 3 * D, *cb = P->in[12] + (size_t)j * D;
    const int wv = tidx >> 6, lane = tidx & 63;
    const int nunits = (MT / CG_ROWS) * 2;
    for (int unit = blockIdx.x * 8 + wv; unit < nunits; unit += gridDim.x * 8) {
        const int half = unit & 1, t0 = (unit >> 1) * CG_ROWS, c8 = half * 512 + lane * 8;
        float w0[8], w1[8], w2[8], bb[8], qp[8], qc[8], qn[8];
        load8f(cw + c8, w0); load8f(cw + D + c8, w1); load8f(cw + 2 * D + c8, w2); load8f(cb + c8, bb);
        const bf16_t* row = Pb + (size_t)t0 * 2048 + c8;
        if (t0 > 0) unpack8(*(const u32x4*)(row - 2048), qp);
        else {
#pragma unroll
            for (int e = 0; e < 8; ++e) qp[e] = 0.f; }
        unpack8(*(const u32x4*)(row), qc);
        for (int i = 0; i < CG_ROWS; ++i, row += 2048) {
            const int l = (t0 + i) & (SEQL - 1);
            float bg[8], o[8];
            unpack8(*(const u32x4*)(row + D), bg);
            if (t0 + i + 1 < MT) unpack8(*(const u32x4*)(row + 2048), qn);
            else {
#pragma unroll
                for (int e = 0; e < 8; ++e) qn[e] = 0.f; }
            const float mp = l > 0 ? 1.f : 0.f, mn = l < SEQL - 1 ? 1.f : 0.f;
#pragma unroll
            for (int e = 0; e < 8; ++e) { o[e] = bg[e] * (bb[e] + w0[e] * (mp * qp[e]) + w1[e] * qc[e] + w2[e] * (mn * qn[e])); qp[e] = qc[e]; qc[e] = qn[e]; }
            *(u32x4*)(A + (size_t)(t0 + i) * D + c8) = pack8(o);
        }
    }
}

__device__ void phase_ffn_fix(PP P, int wid, int layer) {
    const int tidx = fresh_tid(wid);
    const bf16_t* eb = (const bf16_t*)(P->ws + WS_EB);
    bf16_t* G = (bf16_t*)(P->ws + WS_BIG);
    const float* cw = P->in[24] + (size_t)layer * 3 * F2;
    for (int it = blockIdx.x * NTHREADS + tidx; it < NQ * 2 * 352; it += gridDim.x * NTHREADS) {
        const int c8 = (it % 352) * 8, qs = it / 352, q = qs >> 1, sd = qs & 1;
        const int row = q * 64 + (sd ? 63 : 0), l = row & (SEQL - 1);
        const int cg = c8 >> 3;
        const bf16_t* me = eb + ((size_t)((q * 2 + sd) * 352 + cg) * 4) * 8;
        float pa[8], pv[8];
        unpack8(*(const u32x4*)(me + 16), pa); unpack8(*(const u32x4*)(me + 24), pv);
        const bool has_nb = sd ? (l < SEQL - 1) : (l > 0);
        if (has_nb) {
            const bf16_t* nb = eb + ((size_t)(((sd ? q + 1 : q - 1) * 2 + (sd ? 0 : 1)) * 352 + cg) * 4) * 8;
            float ra[8], rv[8], wa[8], wv[8];
            unpack8(*(const u32x4*)(nb), ra); unpack8(*(const u32x4*)(nb + 8), rv);
            load8f(cw + (sd ? 2 : 0) * F2 + c8, wa); load8f(cw + (sd ? 2 : 0) * F2 + F + c8, wv);
#pragma unroll
            for (int e = 0; e < 8; ++e) { pa[e] += wa[e] * ra[e]; pv[e] += wv[e] * rv[e]; }
        }
        float o[8];
#pragma unroll
        for (int e = 0; e < 8; ++e) o[e] = gelu_tanh(pa[e]) * pv[e];
        *(u32x4*)(G + (size_t)row * F + c8) = pack8(o);
    }
}

__device__ __forceinline__ void scan_thread(PP P, int j, int seq, int g, int k, int p) {
    const bf16_t* E = (const bf16_t*)(P->ws + WS_A);
    bf16_t* X = (bf16_t*)(P->ws + WS_BIG);
    const size_t pbase = ((size_t)(j * 2 + k) * NG + g);
    const float dt = expf(P->in[16][pbase]);
    const float lr = P->in[14][pbase * 64 + p], li = P->in[15][pbase * 64 + p];
    const float mag = expf(lr * dt * (float)TCH), ang = li * dt * (float)TCH;
    const float ar = mag * cosf(ang), ai = mag * sinf(ang);
    float sr = 0.f, si = 0.f;
    const size_t rbase = (size_t)g * XR + (size_t)seq * NCHUNK;
    for (int cb = 0; cb < NCHUNK; cb += 8) {
        float er[8], ei[8];
#pragma unroll
        for (int q = 0; q < 8; ++q) { const int c = k == 0 ? cb + q : NCHUNK - 1 - (cb + q); const size_t r = rbase + c;
            er[q] = __uint_as_float((unsigned)E[r * 256 + k * 128 + p] << 16); ei[q] = __uint_as_float((unsigned)E[r * 256 + k * 128 + 64 + p] << 16); }
#pragma unroll
        for (int q = 0; q < 8; ++q) { const int c = k == 0 ? cb + q : NCHUNK - 1 - (cb + q); const size_t r = rbase + c;
            X[r * XLD + 512 + k * 128 + p] = (bf16_t)(cvt_pk_bf16(sr, 0.f) & 0xffffu);
            X[r * XLD + 512 + k * 128 + 64 + p] = (bf16_t)(cvt_pk_bf16(si, 0.f) & 0xffffu);
            const float nr = ar * sr - ai * si + er[q], ni = ar * si + ai * sr + ei[q];
            sr = nr; si = ni; }
    }
}
__device__ void phase_scan_local(PP P, int wid, int j) {
    const int tidx = fresh_tid(wid);
    StaticOrder S; S.init(NG * XR / BM, 1, gridDim.x, blockIdx.x);
    Unit u;
    for (int i = 0; S.next(i, u); ++i) {
        const int g = u.pm / (XR / BM), pml = u.pm - g * (XR / BM);
        scan_thread(P, j, pml * 4 + (tidx >> 7), g, (tidx >> 6) & 1, tidx & 63);
    }
}

#define XB_TMO      128
#define XB_XCNT(j)  (256  + 64 * (j))
#define XB_XSUB(j)  (1280 + 64 * (j))
#define XB_XGEN(j)  (2304 + 64 * (j))
#define XB_TOP      3328
#define XB_TOPGEN   3392
#define XCD_BAR_WORDS 3456
#define XB_SPIN_CAP (1u << 18)
__device__ __forceinline__ unsigned xb_ld(unsigned* p)              { return __hip_atomic_load(p, __ATOMIC_RELAXED, __HIP_MEMORY_SCOPE_AGENT); }
__device__ __forceinline__ unsigned xb_add(unsigned* p, unsigned v) { return __hip_atomic_fetch_add(p, v, __ATOMIC_RELAXED, __HIP_MEMORY_SCOPE_AGENT); }
__device__ __forceinline__ unsigned xb_xcc_id() { return (unsigned)__builtin_amdgcn_s_getreg((3 << 11) | 20) & 0xFu; }
#define XB_SPIN(cond, bar) do { unsigned _sp = 0; while (cond) { __builtin_amdgcn_s_sleep(1); \
    if ((++_sp & 255u) == 0u) { if (xb_ld(&(bar)[XB_TMO])) break; if (_sp > XB_SPIN_CAP) { atomicAdd(&(bar)[XB_TMO], 1u); break; } } } } while (0)
struct XcdBarrier { unsigned* bar; unsigned x; volatile LAS unsigned* st; };
__device__ __forceinline__ XcdBarrier xcd_barrier_post(unsigned* bar, volatile LAS unsigned* st) {
    XcdBarrier b; b.bar = bar; b.x = xb_xcc_id(); b.st = st;
    if (threadIdx.x == 0) (void)xb_add(&bar[XB_XCNT(b.x)], 1u);
    return b;
}
__device__ __forceinline__ void xcd_barrier_complete(unsigned* bar, unsigned x, unsigned& nloc, unsigned& nx) {
    const unsigned G = gridDim.x * gridDim.y * gridDim.z;
    unsigned sum, cnt, mine, sp = 0u;
    for (;;) {
        sum = 0u; cnt = 0u; mine = 0u;
#pragma unroll
        for (unsigned j = 0; j < 16; ++j) { const unsigned c = xb_ld(&bar[XB_XCNT(j)]); sum += c; cnt += (c > 0u) ? 1u : 0u; mine = (j == x) ? c : mine; }
        if (sum == G) break;
        __builtin_amdgcn_s_sleep(1);
        if ((++sp & 255u) == 0u) { if (xb_ld(&bar[XB_TMO])) break; if (sp > XB_SPIN_CAP) { atomicAdd(&bar[XB_TMO], 1u); break; } }
    }
    nloc = mine > 0u ? mine : 1u; nx = cnt > 0u ? cnt : 1u;
}
__device__ __forceinline__ void xcd_barrier(int wid, LAS unsigned char* lds) {
    asm volatile("s_waitcnt vmcnt(0)" ::: "memory");
    __syncthreads();
    if (wid == 0 && fresh_lane() == 0) {
        PP P = (PP)__builtin_amdgcn_kernarg_segment_ptr(); asm volatile("" : "+s"(P));
        XcdBarrier b; b.bar = (unsigned*)(P->ws + WS_BAR); b.x = xb_xcc_id(); b.st = (volatile LAS unsigned*)(lds + LDS_STAGE);
        unsigned* bar = b.bar;
        __builtin_amdgcn_s_waitcnt(0);
        unsigned nloc = b.st[0], nx = b.st[1];
        if (nloc == 0u) { xcd_barrier_complete(bar, b.x, nloc, nx); b.st[0] = nloc; b.st[1] = nx; }
        const unsigned old = xb_add(&bar[XB_XSUB(b.x)], 1u);
        const unsigned gen = old / nloc;
        if (old + 1u == (gen + 1u) * nloc) {
            __builtin_amdgcn_fence(__ATOMIC_RELEASE, "agent");
            asm volatile("s_waitcnt vmcnt(0)" ::: "memory");
            const unsigned og = xb_add(&bar[XB_TOP], 1u);
            const unsigned tg = og / nx;
            if (og + 1u == (tg + 1u) * nx) xb_add(&bar[XB_TOPGEN], 1u);
            else XB_SPIN(xb_ld(&bar[XB_TOPGEN]) == tg, bar);
            __builtin_amdgcn_fence(__ATOMIC_ACQUIRE, "agent");
            xb_add(&bar[XB_XGEN(b.x)], 1u);
            asm volatile("s_waitcnt vmcnt(0)" ::: "memory");
        } else {
            XB_SPIN(xb_ld(&bar[XB_XGEN(b.x)]) == gen, bar);
            __builtin_amdgcn_fence(__ATOMIC_ACQUIRE, "agent");
            asm volatile("s_waitcnt vmcnt(0)" ::: "memory");
        }
    }
    __syncthreads();
}

#define PROBE 0
__global__ void __launch_bounds__(NTHREADS, 2) fwd_megakernel(Params Parg) {
    extern __shared__ __attribute__((aligned(16))) unsigned char lds_raw[];
    LAS unsigned char* lds = (LAS unsigned char*)lds_raw;
    cg::grid_group grid = cg::this_grid();
    const int wid = __builtin_amdgcn_readfirstlane((int)threadIdx.x >> 6);
    volatile LAS unsigned* xb_st = (volatile LAS unsigned*)(lds + LDS_STAGE);
    if (threadIdx.x == 0) { xb_st[0] = 0u; xb_st[1] = 0u; xb_st[2] = 0u; xb_st[3] = 0u; }
    __syncthreads();
    { PP P0 = (PP)__builtin_amdgcn_kernarg_segment_ptr(); (void)xcd_barrier_post((unsigned*)(P0->ws + WS_BAR), xb_st); }
    {
        PP P = (PP)__builtin_amdgcn_kernarg_segment_ptr(); asm volatile("" : "+s"(P));
        for (int rep = 0; rep < (PROBE == 6 ? 2 : 1); ++rep)
        for (int item = blockIdx.x; item < IT_TOTAL; item += gridDim.x) phase0_item(P, wid, lds, item);
    }
    grid.sync();
    {
        PP P = (PP)__builtin_amdgcn_kernarg_segment_ptr(); asm volatile("" : "+s"(P));
        phase_ymat_toeplitz(P, wid);
        phase_modulate0(P, wid);
    }
    xcd_barrier(wid, lds);

    for (int layer = 0; layer < DEPTH; ++layer) {
        const int j = layer >> 1, mix = layer & 1, nmix = mix ? 5 : 4;
        for (int st = 0; st < nmix + 4; ++st) {
            PP P = (PP)__builtin_amdgcn_kernarg_segment_ptr(); asm volatile("" : "+s"(P));
            unsigned char* ws = P->ws;
            int kind = 0; GemmD g; EpiG e; int rsub = 0;
            const bf16_t* rusrc = (const bf16_t*)(ws + WS_A); const bf16_t* rsrc = (const bf16_t*)(ws + WS_BIG); bf16_t* rdst = (bf16_t*)(ws + WS_A);
            g.tilesPerBatch = 1 << 30; g.bBatchStride = 0; g.lda = D; g.ldb = D; g.K = D; g.nM = MT / BM; g.nN = 4; g.A = (const bf16_t*)(ws + WS_A); g.Bt = nullptr;
            e.kind = 0; e.O = ws + WS_BIG; e.ldc = D; e.layer = layer; e.first = 0; e.wid = wid; e.lds = lds;
            if (st < nmix) {
                if (!mix) {
                    if (st == 0) { g.Bt = (const bf16_t*)(ws + WS_WIN + j * SZ_WIN); g.nN = 3072 / BM; e.kind = 6; }
                    else if (st == 1) kind = 1;
                    else if (st == 2) { g.A = (const bf16_t*)P->out; g.Bt = (const bf16_t*)(ws + WS_WOUT + j * SZ_WOUT); }
                    else { kind = 2; rsub = 0; }
                } else {
                    if (st == 0) { g.A = (const bf16_t*)(ws + WS_BIG); g.Bt = (const bf16_t*)(ws + WS_EMAT + j * SZ_EMAT); g.lda = XLD; g.ldb = 512; g.K = 512; g.nM = NG * XR / BM; g.nN = 1; g.tilesPerBatch = XR / BM; g.bBatchStride = (size_t)256 * 512;
                        e.kind = 0; e.ldc = 256; e.O = ws + WS_A; }
                    else if (st == 1) kind = 3;
                    else if (st == 2) { g.A = (const bf16_t*)(ws + WS_BIG); g.Bt = (const bf16_t*)(ws + WS_YMAT + j * SZ_YMAT); g.lda = XLD; g.ldb = XLD; g.K = XLD; g.nM = NG * XR / BM; g.nN = 2; g.tilesPerBatch = XR / BM; g.bBatchStride = (size_t)512 * XLD;
                        e.kind = 2; e.O = ws + WS_A; }
                    else if (st == 3) { g.Bt = (const bf16_t*)(ws + WS_WGLU + j * SZ_WGLU); g.nN = 2048 / BM; e.kind = 5; e.O = P->out; }
                    else { kind = 2; rsub = 0; rusrc = (const bf16_t*)(ws + WS_BIG); rsrc = (const bf16_t*)P->out; }
                }
            } else {
                const int f = st - nmix;
                unsigned char* mbuf = layer == DEPTH - 1 ? ws + WS_DEAD : (unsigned char*)P->out;
                if (f == 0) { g.Bt = (const bf16_t*)(ws + WS_WUP + layer * SZ_WUP); g.nN = F2 / BM; e.kind = 3; }
                else if (f == 1) kind = 4;
                else if (f == 2) { g.A = (const bf16_t*)(ws + WS_BIG); g.Bt = (const bf16_t*)(ws + WS_WDN + layer * SZ_WDN); g.lda = F; g.ldb = F; g.K = F; e.O = mbuf; }
                else { kind = 2; rsub = 1; rsrc = (const bf16_t*)mbuf; if (layer + 1 < DEPTH && ((layer + 1) & 1)) rdst = (bf16_t*)(ws + WS_BIG); }
            }
            int reps = 1;
            if (PROBE == 1 && kind == 0) reps = 2;
            if (PROBE == 4 && kind == 0 && e.kind == 0) reps = 2;
            if (PROBE == 5 && kind == 0 && e.kind == 3) reps = 2;
            if (PROBE == 2 && kind != 0 && kind != 2) reps = 2;
            for (int rep = 0; rep < reps; ++rep) {
            if (kind == 0) gemm_phase(lds, g, e);
            else if (kind == 1) phase_convgate(P, wid, j);
            else if (kind == 2) phase_resid_ln(P, wid, layer, rsub, rusrc, rsrc, rdst);
            else if (kind == 3) phase_scan_local(P, wid, j);
            else phase_ffn_fix(P, wid, layer);
            if (!(mix && st == 0)) xcd_barrier(wid, lds);
            }
            if (PROBE == 3) { xcd_barrier(wid, lds); xcd_barrier(wid, lds); }
        }
    }
}

extern "C" void kernel_launch(void* const* d_in, const int* in_sizes, int n_in, void* d_out, int out_size, void* d_ws, size_t ws_size, hipStream_t stream) {
    static int grid_blocks = 0;
    if (grid_blocks == 0) {
        if (n_in != 27 || ws_size < WS_TOTAL) { fprintf(stderr, "kernel_launch: need 27 inputs and %zu bytes of workspace (got %d, %zu)\n", (size_t)WS_TOTAL, n_in, ws_size); grid_blocks = -1; return; }
        int dev = 0, cus = 0, per_cu = 0;
        hipGetDevice(&dev);
        hipDeviceGetAttribute(&cus, hipDeviceAttributeMultiprocessorCount, dev);
        if (hipFuncSetAttribute((const void*)fwd_megakernel, hipFuncAttributeMaxDynamicSharedMemorySize, LDS_BYTES) != hipSuccess) { fprintf(stderr, "hipFuncSetAttribute failed\n"); grid_blocks = -1; return; }
        hipOccupancyMaxActiveBlocksPerMultiprocessor(&per_cu, (const void*)fwd_megakernel, NTHREADS, LDS_BYTES);
        if (per_cu < 1) { fprintf(stderr, "occupancy query says %d blocks per CU\n", per_cu); per_cu = 1; }
        grid_blocks = cus * 1;
        (void)hipGetLastError();
    }
    if (grid_blocks < 0) return;
    if (hipMemsetAsync((char*)d_ws + WS_BAR, 0, 16384, stream) != hipSuccess) { fprintf(stderr, "memset of barrier words failed\n"); return; }
    Params p{};
    for (int i = 0; i < 27; ++i) p.in[i] = (const float*)d_in[i];
    p.out = (float*)d_out; p.ws = (unsigned char*)d_ws;
    void* args[] = {&p};
    hipError_t e = hipLaunchCooperativeKernel((const void*)fwd_megakernel, dim3(grid_blocks), dim3(NTHREADS), args, LDS_BYTES, stream);
    if (e != hipSuccess) fprintf(stderr, "cooperative launch failed: %s (grid %d)\n", hipGetErrorString(e), grid_blocks);
}
```
